# Optimizing an MI355X kernel written in HIP

```python
import jax, jax.numpy as jnp
from jax import lax
import numpy as np

D_MODEL = 1024
BATCH = 8
SEQ = 4096
DEPTH = 2

CHUNK = 64
MEM_LEN = 256
D_CONV = 3 * D_MODEL // 8
CONV_WIDTH = 31
D_SGU = 3 * D_MODEL // 8
SGU_HEADS = 4
SGU_CHUNK = 128
D_POOL = D_MODEL // 4
POOL_WINDOWS = (2, 4, 8, 16)
POOL_GROUPS = len(POOL_WINDOWS)
D_MIX = D_CONV + D_SGU + D_POOL
D_IN = 2 * D_CONV + 2 * D_SGU + D_POOL
X_HEADS = 4
X_HEAD_DIM = D_MODEL // X_HEADS
D_FF = ((8 * D_MODEL // 3 + 127) // 128) * 128
N_EXPERTS = 8
TOP_K = 2
D_FF_EXPERT = D_FF
N_DENSE = (DEPTH + 1) // 2
N_MOE = DEPTH // 2
EPS = 1e-6

kernel_name = 'hybrid_conv_sgu_pool_moe_block'


def rms_norm(x, g):
    xf = x.astype(jnp.float32)
    y = xf * lax.rsqrt(jnp.mean(xf * xf, axis=-1, keepdims=True) + EPS)
    return (y * g.astype(jnp.float32)).astype(x.dtype)


def layer_norm(x, g, b):
    xf = x.astype(jnp.float32)
    mu = jnp.mean(xf, axis=-1, keepdims=True)
    var = jnp.mean(jnp.square(xf - mu), axis=-1, keepdims=True)
    y = (xf - mu) * lax.rsqrt(var + EPS) * g.astype(jnp.float32) + b.astype(jnp.float32)
    return y.astype(x.dtype)


def conformer_conv(a, conv_w, conv_b, ln_g, ln_b):
    h = a[..., :D_CONV] * jax.nn.sigmoid(a[..., D_CONV:])
    h = lax.conv_general_dilated(
        h, conv_w[:, None, :], window_strides=(1,),
        padding=[(CONV_WIDTH - 1, 0)],
        dimension_numbers=('NWC', 'WIO', 'NWC'),
        feature_group_count=D_CONV) + conv_b
    h = layer_norm(h, ln_g, ln_b)
    return jax.nn.silu(h)


def spatial_gating(z, ln_g, ln_b, sgu_w, sgu_b):
    z = jax.nn.gelu(z)
    u, v = z[..., :D_SGU], z[..., D_SGU:]
    v = layer_norm(v, ln_g, ln_b)
    B, S, _ = v.shape
    v = v.reshape(B, S // SGU_CHUNK, SGU_CHUNK, SGU_HEADS, D_SGU // SGU_HEADS)
    blk = jnp.arange(SGU_CHUNK) // CHUNK
    mask = blk[:, None] >= blk[None, :]
    w = jnp.where(mask[None], sgu_w, 0)
    s = jnp.einsum('hij,bcjhd->bcihd', w, v) + sgu_b.T[None, None, :, :, None]
    return u * s.reshape(B, S, D_SGU)


def multiscale_pool(c, pool_w, pool_b, pool_scale):
    B, S, _ = c.shape
    gd = D_POOL // POOL_GROUPS
    cf = c.astype(jnp.float32)
    pos = jnp.arange(S)
    outs = []
    for gi, w in enumerate(POOL_WINDOWS):
        cg = cf[..., gi * gd:(gi + 1) * gd]
        cs = jnp.cumsum(cg, axis=1)
        prev = jnp.pad(cs, ((0, 0), (w, 0), (0, 0)))[:, :S]
        cnt = jnp.minimum(pos + 1, w).astype(jnp.float32)[None, :, None]
        outs.append((cs - prev) / cnt - cg)
    p = jnp.stack(outs, axis=2).astype(c.dtype)
    y = jnp.einsum('bsgi,gio->bsgo', p, pool_w) + pool_b
    return y.reshape(B, S, D_POOL) * pool_scale


def memory_cross_attention(h, m, wq, wk, wv, wo):
    B, S, D = h.shape
    M = m.shape[1]
    q = (h @ wq).reshape(B, S, X_HEADS, X_HEAD_DIM)
    k = (m @ wk).reshape(B, M, X_HEADS, X_HEAD_DIM)
    v = (m @ wv).reshape(B, M, X_HEADS, X_HEAD_DIM)
    s = jnp.einsum('bshd,bmhd->bhsm', q, k).astype(jnp.float32) * (X_HEAD_DIM ** -0.5)
    p = jax.nn.softmax(s, axis=-1).astype(h.dtype)
    o = jnp.einsum('bhsm,bmhd->bshd', p, v).reshape(B, S, D)
    return o @ wo


def swiglu(h, wg, wu, wd):
    return (jax.nn.silu(h @ wg) * (h @ wu)) @ wd


def moe_swiglu(h, router_w, wg, wu, wd):
    B, S, D = h.shape
    t = h.reshape(B * S, D)
    logits = (t @ router_w).astype(jnp.float32)
    top_v, top_i = lax.top_k(logits, TOP_K)
    gates = jax.nn.softmax(top_v, axis=-1)
    combine = jnp.sum(jax.nn.one_hot(top_i, N_EXPERTS, dtype=jnp.float32) * gates[..., None], axis=1)
    combine = combine.astype(h.dtype)
    y = jnp.zeros_like(t)
    for e in range(N_EXPERTS):
        y = y + combine[:, e:e + 1] * swiglu(t, wg[e], wu[e], wd[e])
    return y.reshape(B, S, D)


def setup_inputs(seed: int = 0) -> dict:
    key = jax.random.key(seed)
    keys = jax.random.split(key, 32)
    cnt = [0]
    f32 = jnp.float32

    def nk():
        k = keys[cnt[0]]
        cnt[0] += 1
        return k

    def nrm(shape, scale):
        return jax.random.normal(nk(), shape, f32) * scale

    def gain(shape):
        return 1.0 + nrm(shape, 0.02)

    L, D = DEPTH, D_MODEL
    gd = D_POOL // POOL_GROUPS
    return {
        'x': nrm((BATCH, SEQ, D), 1.0),
        'mem': nrm((BATCH, MEM_LEN, D), 1.0),
        'mix_norm_g': gain((L, D)),
        'w_in': nrm((L, D, D_IN), D ** -0.5),
        'conv_w': nrm((L, CONV_WIDTH, D_CONV), CONV_WIDTH ** -0.5),
        'conv_b': nrm((L, D_CONV), 0.02),
        'conv_ln_g': gain((L, D_CONV)),
        'conv_ln_b': nrm((L, D_CONV), 0.02),
        'sgu_ln_g': gain((L, D_SGU)),
        'sgu_ln_b': nrm((L, D_SGU), 0.02),
        'sgu_w': nrm((L, SGU_HEADS, SGU_CHUNK, SGU_CHUNK), SGU_CHUNK ** -0.5),
        'sgu_b': 1.0 + nrm((L, SGU_HEADS, SGU_CHUNK), 0.1),
        'pool_w': nrm((L, POOL_GROUPS, gd, gd), gd ** -0.5),
        'pool_b': nrm((L, POOL_GROUPS, gd), 0.02),
        'pool_scale': 1.0 + nrm((L, D_POOL), 0.05),
        'w_out': nrm((L, D_MIX, D), D_MIX ** -0.5),
        'xattn_norm_g': gain((L, D)),
        'mem_norm_g': gain((L, D)),
        'xattn_wq': nrm((L, D, D), D ** -0.5),
        'xattn_wk': nrm((L, D, D), D ** -0.5),
        'xattn_wv': nrm((L, D, D), D ** -0.5),
        'xattn_wo': nrm((L, D, D), D ** -0.5),
        'ffn_norm_g': gain((L, D)),
        'ffn_wg': nrm((N_DENSE, D, D_FF), D ** -0.5),
        'ffn_wu': nrm((N_DENSE, D, D_FF), D ** -0.5),
        'ffn_wd': nrm((N_DENSE, D_FF, D), D_FF ** -0.5),
        'router_w': nrm((N_MOE, D, N_EXPERTS), D ** -0.5),
        'moe_wg': nrm((N_MOE, N_EXPERTS, D, D_FF_EXPERT), D ** -0.5),
        'moe_wu': nrm((N_MOE, N_EXPERTS, D, D_FF_EXPERT), D ** -0.5),
        'moe_wd': nrm((N_MOE, N_EXPERTS, D_FF_EXPERT, D), D_FF_EXPERT ** -0.5),
        'final_norm_g': gain((D,)),
    }


def reference(x, mem, mix_norm_g, w_in, conv_w, conv_b, conv_ln_g, conv_ln_b,
              sgu_ln_g, sgu_ln_b, sgu_w, sgu_b, pool_w, pool_b, pool_scale, w_out,
              xattn_norm_g, mem_norm_g, xattn_wq, xattn_wk, xattn_wv, xattn_wo,
              ffn_norm_g, ffn_wg, ffn_wu, ffn_wd, router_w, moe_wg, moe_wu, moe_wd,
              final_norm_g):
    a_end = 2 * D_CONV
    b_end = a_end + 2 * D_SGU
    for l in range(DEPTH):
        h = rms_norm(x, mix_norm_g[l])
        z = h @ w_in[l]
        y_a = conformer_conv(z[..., :a_end], conv_w[l], conv_b[l], conv_ln_g[l], conv_ln_b[l])
        y_b = spatial_gating(z[..., a_end:b_end], sgu_ln_g[l], sgu_ln_b[l], sgu_w[l], sgu_b[l])
        y_c = multiscale_pool(z[..., b_end:], pool_w[l], pool_b[l], pool_scale[l])
        mixed = jnp.concatenate([y_a, y_b, y_c], axis=-1)
        x = x + mixed @ w_out[l]
        h = rms_norm(x, xattn_norm_g[l])
        m = rms_norm(mem, mem_norm_g[l])
        x = x + memory_cross_attention(h, m, xattn_wq[l], xattn_wk[l], xattn_wv[l], xattn_wo[l])
        h = rms_norm(x, ffn_norm_g[l])
        if l % 2 == 0:
            j = l // 2
            x = x + swiglu(h, ffn_wg[j], ffn_wu[j], ffn_wd[j])
        else:
            j = l // 2
            x = x + moe_swiglu(h, router_w[j], moe_wg[j], moe_wu[j], moe_wd[j])
    return rms_norm(x, final_norm_g)
```

```cpp
#include <hip/hip_runtime.h>
#include <stdint.h>

#define XB_TMO      128
#define XB_XCNT(j)  (256  + 64 * (j))
#define XB_XSUB(j)  (1280 + 64 * (j))
#define XB_XGEN(j)  (2304 + 64 * (j))
#define XB_TOP      3328
#define XB_TOPGEN   3392
#define XCD_BAR_WORDS 3456
#define XB_SPIN_CAP (1u << 22)
#define LAS __attribute__((address_space(3)))

__device__ __forceinline__ unsigned xb_ld(unsigned* p)              { return __hip_atomic_load(p, __ATOMIC_RELAXED, __HIP_MEMORY_SCOPE_AGENT); }
__device__ __forceinline__ unsigned xb_add(unsigned* p, unsigned v) { return __hip_atomic_fetch_add(p, v, __ATOMIC_RELAXED, __HIP_MEMORY_SCOPE_AGENT); }
__device__ __forceinline__ unsigned xb_xcc_id() { return (unsigned)__builtin_amdgcn_s_getreg((3 << 11) | 20) & 0xFu; }
#define XB_SPIN(cond, bar) do { unsigned _sp = 0; while (cond) { __builtin_amdgcn_s_sleep(1); \
    if ((++_sp & 255u) == 0u) { if (xb_ld(&(bar)[XB_TMO])) break; if (_sp > XB_SPIN_CAP) { atomicAdd(&(bar)[XB_TMO], 1u); break; } } } } while (0)

struct XcdBarrier { unsigned* bar; unsigned x; volatile LAS unsigned* st; };

__device__ __forceinline__ XcdBarrier xcd_barrier_post(unsigned* bar, volatile LAS unsigned* st) {
    XcdBarrier b; b.bar = bar; b.x = xb_xcc_id(); b.st = st;
    if (threadIdx.x == 0) (void)xb_add(&bar[XB_XCNT(b.x)], 1u);
    return b;
}
__device__ __forceinline__ void xcd_barrier_complete(unsigned* bar, unsigned x, unsigned& nloc, unsigned& nx) {
    const unsigned G = gridDim.x * gridDim.y * gridDim.z;
    unsigned sum, cnt, mine, sp = 0u;
    for (;;) {
        sum = 0u; cnt = 0u; mine = 0u;
#pragma unroll
        for (unsigned j = 0; j < 16; ++j) { const unsigned c = xb_ld(&bar[XB_XCNT(j)]); sum += c; cnt += (c > 0u) ? 1u : 0u; mine = (j == x) ? c : mine; }
        if (sum == G) break;
        __builtin_amdgcn_s_sleep(1);
        if ((++sp & 255u) == 0u) { if (xb_ld(&bar[XB_TMO])) break; if (sp > XB_SPIN_CAP) { atomicAdd(&bar[XB_TMO], 1u); break; } }
    }
    nloc = mine > 0u ? mine : 1u; nx = cnt > 0u ? cnt : 1u;
}
__device__ __forceinline__ void xcd_barrier(const XcdBarrier& b) {
    asm volatile("s_waitcnt vmcnt(0)" ::: "memory");
    __syncthreads();
    if (threadIdx.x == 0) {
        unsigned* bar = b.bar;
        __builtin_amdgcn_s_waitcnt(0);
        unsigned nloc = b.st[0], nx = b.st[1];
        if (nloc == 0u) { xcd_barrier_complete(bar, b.x, nloc, nx); b.st[0] = nloc; b.st[1] = nx; }
        const unsigned old = xb_add(&bar[XB_XSUB(b.x)], 1u);
        const unsigned gen = old / nloc;
        if (old + 1u == (gen + 1u) * nloc) {
            __builtin_amdgcn_fence(__ATOMIC_RELEASE, "agent");
            asm volatile("s_waitcnt vmcnt(0)" ::: "memory");
            const unsigned og = xb_add(&bar[XB_TOP], 1u);
            const unsigned tg = og / nx;
            if (og + 1u == (tg + 1u) * nx) xb_add(&bar[XB_TOPGEN], 1u);
            else XB_SPIN(xb_ld(&bar[XB_TOPGEN]) == tg, bar);
            __builtin_amdgcn_fence(__ATOMIC_ACQUIRE, "agent");
            xb_add(&bar[XB_XGEN(b.x)], 1u);
            asm volatile("s_waitcnt vmcnt(0)" ::: "memory");
        } else {
            XB_SPIN(xb_ld(&bar[XB_XGEN(b.x)]) == gen, bar);
            __builtin_amdgcn_fence(__ATOMIC_ACQUIRE, "agent");
            asm volatile("s_waitcnt vmcnt(0)" ::: "memory");
        }
    }
    __syncthreads();
}

typedef unsigned short bf16_t;
typedef short s16x4 __attribute__((ext_vector_type(4)));
typedef float f32x16 __attribute__((ext_vector_type(16)));

__device__ __forceinline__ bf16_t f2bf(float f) { unsigned u = __float_as_uint(f); u += 0x7fffu + ((u >> 16) & 1u); return (bf16_t)(u >> 16); }
__device__ __forceinline__ float bf2f(bf16_t h) { return __uint_as_float(((unsigned)h) << 16); }
__device__ __forceinline__ unsigned pack2(float a, float b) { return (unsigned)f2bf(a) | ((unsigned)f2bf(b) << 16); }
__device__ __forceinline__ float wsum(float v) {
#pragma unroll
    for (int o = 32; o > 0; o >>= 1) v += __shfl_xor(v, o, 64);
    return v;
}
__device__ __forceinline__ float wmax(float v) {
#pragma unroll
    for (int o = 32; o > 0; o >>= 1) v = fmaxf(v, __shfl_xor(v, o, 64));
    return v;
}
__device__ __forceinline__ float gelu_t(float x) { return 0.5f * x * (1.f + tanhf(0.7978845608028654f * (x + 0.044715f * x * x * x))); }
__device__ __forceinline__ float sigm(float x) { return 1.f / (1.f + __expf(-x)); }

constexpr int T = 32768, D = 1024, S = 4096, DIN = 1792, DFF = 2816, NE = 8;
constexpr int LDS_BYTES = 65536 + 49152 + 1024;

struct GemmP {
    const bf16_t* A; long lda; const int* gatherA;
    const void* B; const void* B2; long ldb;
    int M, N, K, nbatch;
    long aB1, aB2, bB1, bB2, cB1, cB2;
    void* C; long ldc; const float* R; float scale; const int* scatter; const float* gate;
};
template <int BMODE, int EPI, bool DUAL>
__device__ __forceinline__ void gemm(const GemmP& p, char* smem) {
    bf16_t* sA = (bf16_t*)smem;
    bf16_t* sB = sA + 128 * 40;
    int tid = threadIdx.x; asm volatile("" : "+v"(tid));
    const int lane = tid & 63, wave = tid >> 6, wr = wave >> 1, wc = wave & 1;
    const int mt = (p.M + 127) >> 7, nt = p.N >> 7, per = mt * nt, total = per * p.nbatch, nk = p.K >> 5;
    for (int tile = blockIdx.x; tile < total; tile += gridDim.x) {
        const int batch = tile / per, rem = tile - batch * per, tm = rem / nt, tn = rem - tm * nt;
        const long aoff = (long)(batch >> 2) * p.aB1 + (long)(batch & 3) * p.aB2;
        const long boff = (long)(batch >> 2) * p.bB1 + (long)(batch & 3) * p.bB2;
        const long coff = (long)(batch >> 2) * p.cB1 + (long)(batch & 3) * p.cB2;
        const bf16_t *arow0, *arow1;
        {
            int r0 = tm * 128 + (tid >> 2), r1 = r0 + 64; if (r0 >= p.M) r0 = p.M - 1; if (r1 >= p.M) r1 = p.M - 1;
            const long s0 = p.gatherA ? (long)p.gatherA[r0] : (long)r0, s1 = p.gatherA ? (long)p.gatherA[r1] : (long)r1;
            arow0 = p.A + aoff + s0 * p.lda + (tid & 3) * 8; arow1 = p.A + aoff + s1 * p.lda + (tid & 3) * 8;
        }
        uint4 ar0, ar1;
        float bfv[DUAL ? 32 : 16];
        unsigned bu[16];
        const int bn = tid & 127, bkh = tid >> 7;
        auto loadg = [&](int kt) {
            const int k0 = kt * 32;
            ar0 = *(const uint4*)(arow0 + k0); ar1 = *(const uint4*)(arow1 + k0);
            if constexpr (BMODE == 0) {
                const float* Bp = (const float*)p.B + boff + tn * 128 + bn;
#pragma unroll
                for (int j = 0; j < 4; ++j)
#pragma unroll
                    for (int q = 0; q < 4; ++q) bfv[j * 4 + q] = Bp[(long)(k0 + (bkh + 2 * j) * 4 + q) * p.ldb];
                if constexpr (DUAL) {
                    const float* Bq = (const float*)p.B2 + boff + tn * 128 + bn;
#pragma unroll
                    for (int j = 0; j < 4; ++j)
#pragma unroll
                        for (int q = 0; q < 4; ++q) bfv[16 + j * 4 + q] = Bq[(long)(k0 + (bkh + 2 * j) * 4 + q) * p.ldb];
                }
            } else if constexpr (BMODE == 1) {
                const bf16_t* Bp = (const bf16_t*)p.B + boff + (long)(tn * 128 + (tid >> 1)) * p.ldb + k0 + (tid & 1) * 16;
                const uint4 v0 = *(const uint4*)Bp, v1 = *(const uint4*)(Bp + 8);
                bu[0] = v0.x; bu[1] = v0.y; bu[2] = v0.z; bu[3] = v0.w; bu[4] = v1.x; bu[5] = v1.y; bu[6] = v1.z; bu[7] = v1.w;
            } else {
                const bf16_t* Bp = (const bf16_t*)p.B + boff + tn * 128 + bn;
#pragma unroll
                for (int j = 0; j < 4; ++j)
#pragma unroll
                    for (int q = 0; q < 4; ++q) bu[j * 4 + q] = Bp[(long)(k0 + (bkh + 2 * j) * 4 + q) * p.ldb];
            }
        };
        auto stores = [&]() {
            *(uint4*)(sA + (tid >> 2) * 40 + (tid & 3) * 8) = ar0; *(uint4*)(sA + ((tid >> 2) + 64) * 40 + (tid & 3) * 8) = ar1;
            if constexpr (BMODE == 0) {
#pragma unroll
                for (int j = 0; j < 4; ++j) {
                    uint2 v; v.x = pack2(bfv[j * 4], bfv[j * 4 + 1]); v.y = pack2(bfv[j * 4 + 2], bfv[j * 4 + 3]);
                    *(uint2*)(sB + bn * 40 + (bkh + 2 * j) * 4) = v;
                    if constexpr (DUAL) {
                        uint2 w; w.x = pack2(bfv[16 + j * 4], bfv[16 + j * 4 + 1]); w.y = pack2(bfv[16 + j * 4 + 2], bfv[16 + j * 4 + 3]);
                        *(uint2*)(sB + (128 + bn) * 40 + (bkh + 2 * j) * 4) = w;
                    }
                }
            } else if constexpr (BMODE == 1) {
                uint4 v0, v1; v0.x = bu[0]; v0.y = bu[1]; v0.z = bu[2]; v0.w = bu[3]; v1.x = bu[4]; v1.y = bu[5]; v1.z = bu[6]; v1.w = bu[7];
                bf16_t* d = sB + (tid >> 1) * 40 + (tid & 1) * 16;
                *(uint4*)d = v0; *(uint4*)(d + 8) = v1;
            } else {
#pragma unroll
                for (int j = 0; j < 4; ++j) {
                    uint2 v; v.x = bu[j * 4] | (bu[j * 4 + 1] << 16); v.y = bu[j * 4 + 2] | (bu[j * 4 + 3] << 16);
                    *(uint2*)(sB + bn * 40 + (bkh + 2 * j) * 4) = v;
                }
            }
        };
        f32x16 acc[2][2], acc2[2][2];
#pragma unroll
        for (int a = 0; a < 2; ++a)
#pragma unroll
            for (int b = 0; b < 2; ++b)
#pragma unroll
                for (int i = 0; i < 16; ++i) { acc[a][b][i] = 0.f; acc2[a][b][i] = 0.f; }
        loadg(0);
#pragma unroll 1
        for (int kt = 0; kt < nk; ++kt) {
            __syncthreads();
            stores();
            __syncthreads();
            if (kt + 1 < nk) loadg(kt + 1);
#pragma unroll
            for (int ks = 0; ks < 4; ++ks) {
                const int kk = ks * 8 + (lane >> 5) * 4;
                s16x4 af[2], bfr[2], bf2[2];
#pragma unroll
                for (int mi = 0; mi < 2; ++mi) af[mi] = *(const s16x4*)(sA + (wr * 64 + mi * 32 + (lane & 31)) * 40 + kk);
#pragma unroll
                for (int ni = 0; ni < 2; ++ni) {
                    bfr[ni] = *(const s16x4*)(sB + (wc * 64 + ni * 32 + (lane & 31)) * 40 + kk);
                    if constexpr (DUAL) bf2[ni] = *(const s16x4*)(sB + (128 + wc * 64 + ni * 32 + (lane & 31)) * 40 + kk);
                }
#pragma unroll
                for (int mi = 0; mi < 2; ++mi)
#pragma unroll
                    for (int ni = 0; ni < 2; ++ni) {
                        acc[mi][ni] = __builtin_amdgcn_mfma_f32_32x32x8bf16_1k(af[mi], bfr[ni], acc[mi][ni], 0, 0, 0);
                        if constexpr (DUAL) acc2[mi][ni] = __builtin_amdgcn_mfma_f32_32x32x8bf16_1k(af[mi], bf2[ni], acc2[mi][ni], 0, 0, 0);
                    }
            }
        }
#pragma unroll
        for (int mi = 0; mi < 2; ++mi)
#pragma unroll
            for (int ni = 0; ni < 2; ++ni)
#pragma unroll
                for (int i = 0; i < 16; ++i) {
                    const int r = tm * 128 + wr * 64 + mi * 32 + (i >> 2) * 8 + (lane >> 5) * 4 + (i & 3);
                    const int c = tn * 128 + wc * 64 + ni * 32 + (lane & 31);
                    if (r < p.M) {
                        const float v = acc[mi][ni][i];
                        const long idx = coff + (long)r * p.ldc + c;
                        if constexpr (EPI == 0) ((bf16_t*)p.C)[idx] = f2bf(v);
                        else if constexpr (EPI == 1) ((float*)p.C)[idx] = v * p.scale;
                        else if constexpr (EPI == 2) ((float*)p.C)[idx] = p.R[idx] + v;
                        else if constexpr (EPI == 3) { const float u = acc2[mi][ni][i]; ((bf16_t*)p.C)[idx] = f2bf(v * sigm(v) * u); }
                        else { const long tk = p.scatter[r]; float* x = (float*)p.C + tk * p.ldc + c; *x = *x + p.gate[r] * v; }
                    }
                }
    }
}

template <bool OUTF, bool ROUTER>
__device__ __forceinline__ void rmsnorm_phase(const float* X, const float* g, void* out, int rows,
                                              const float* rw, int* cnt, int* list, float* gatev) {
    int tid = threadIdx.x; asm volatile("" : "+v"(tid));
    const int lane = tid & 63, wave = tid >> 6;
    for (int row = blockIdx.x * 4 + wave; row < rows; row += gridDim.x * 4) {
        const float* xr = X + (long)row * D;
        float4 v[4]; float ss = 0.f;
#pragma unroll
        for (int j = 0; j < 4; ++j) { v[j] = *(const float4*)(xr + (j * 64 + lane) * 4); ss += v[j].x * v[j].x + v[j].y * v[j].y + v[j].z * v[j].z + v[j].w * v[j].w; }
        ss = wsum(ss);
        const float rs = rsqrtf(ss * (1.f / D) + 1e-6f);
        float lg[NE];
        if constexpr (ROUTER) {
#pragma unroll
            for (int e = 0; e < NE; ++e) lg[e] = 0.f;
        }
#pragma unroll
        for (int j = 0; j < 4; ++j) {
            const int c = (j * 64 + lane) * 4;
            const float4 gg = *(const float4*)(g + c);
            float4 y; y.x = v[j].x * rs * gg.x; y.y = v[j].y * rs * gg.y; y.z = v[j].z * rs * gg.z; y.w = v[j].w * rs * gg.w;
            if constexpr (OUTF) *(float4*)((float*)out + (long)row * D + c) = y;
            else { uint2 pk; pk.x = pack2(y.x, y.y); pk.y = pack2(y.z, y.w); *(uint2*)((bf16_t*)out + (long)row * D + c) = pk; }
            if constexpr (ROUTER) {
                const float4 r0 = *(const float4*)(rw + (long)c * NE), r1 = *(const float4*)(rw + (long)c * NE + 4);
                const float4 r2 = *(const float4*)(rw + (long)(c + 1) * NE), r3 = *(const float4*)(rw + (long)(c + 1) * NE + 4);
                const float4 r4 = *(const float4*)(rw + (long)(c + 2) * NE), r5 = *(const float4*)(rw + (long)(c + 2) * NE + 4);
                const float4 r6 = *(const float4*)(rw + (long)(c + 3) * NE), r7 = *(const float4*)(rw + (long)(c + 3) * NE + 4);
                lg[0] += y.x * r0.x + y.y * r2.x + y.z * r4.x + y.w * r6.x; lg[1] += y.x * r0.y + y.y * r2.y + y.z * r4.y + y.w * r6.y;
                lg[2] += y.x * r0.z + y.y * r2.z + y.z * r4.z + y.w * r6.z; lg[3] += y.x * r0.w + y.y * r2.w + y.z * r4.w + y.w * r6.w;
                lg[4] += y.x * r1.x + y.y * r3.x + y.z * r5.x + y.w * r7.x; lg[5] += y.x * r1.y + y.y * r3.y + y.z * r5.y + y.w * r7.y;
                lg[6] += y.x * r1.z + y.y * r3.z + y.z * r5.z + y.w * r7.z; lg[7] += y.x * r1.w + y.y * r3.w + y.z * r5.w + y.w * r7.w;
            }
        }
        if constexpr (ROUTER) {
#pragma unroll
            for (int e = 0; e < NE; ++e) lg[e] = wsum(lg[e]);
            if (lane == 0) {
                int i0 = 0; float v0 = lg[0];
#pragma unroll
                for (int e = 1; e < NE; ++e) if (lg[e] > v0) { v0 = lg[e]; i0 = e; }
                int i1 = -1; float v1 = -3.0e38f;
#pragma unroll
                for (int e = 0; e < NE; ++e) if (e != i0 && lg[e] > v1) { v1 = lg[e]; i1 = e; }
                const float e1 = __expf(v1 - v0), g0 = 1.f / (1.f + e1), g1 = e1 / (1.f + e1);
                const int s0 = atomicAdd(&cnt[i0], 1); list[i0 * T + s0] = row; gatev[i0 * T + s0] = g0;
                const int s1 = atomicAdd(&cnt[i1], 1); list[i1 * T + s1] = row; gatev[i1 * T + s1] = g1;
            }
        }
    }
}

__device__ __forceinline__ void softmax_phase(const float* Sc, bf16_t* P) {
    int tid = threadIdx.x; asm volatile("" : "+v"(tid));
    const int lane = tid & 63, wave = tid >> 6;
    for (int it = blockIdx.x * 4 + wave; it < T * 4; it += gridDim.x * 4) {
        const float4 v = *(const float4*)(Sc + (long)it * 256 + lane * 4);
        const float m = wmax(fmaxf(fmaxf(v.x, v.y), fmaxf(v.z, v.w)));
        const float e0 = __expf(v.x - m), e1 = __expf(v.y - m), e2 = __expf(v.z - m), e3 = __expf(v.w - m);
        const float inv = 1.f / wsum(e0 + e1 + e2 + e3);
        uint2 pk; pk.x = pack2(e0 * inv, e1 * inv); pk.y = pack2(e2 * inv, e3 * inv);
        *(uint2*)(P + (long)it * 256 + lane * 4) = pk;
    }
}

__device__ __forceinline__ void mixer_phase(const bf16_t* Z, bf16_t* MIX, char* smem,
        const float* conv_w, const float* conv_b, const float* cln_g, const float* cln_b,
        const float* sln_g, const float* sln_b, const float* sgu_w, const float* sgu_b,
        const float* pool_w, const float* pool_b, const float* pool_scale) {
    int tid = threadIdx.x; asm volatile("" : "+v"(tid));
    const int lane = tid & 63, wave = tid >> 6;
    for (int unit = blockIdx.x; unit < 256; unit += gridDim.x) {
        const int b = unit >> 5, t0 = (unit & 31) * 128;
        const long rb = (long)b * S;
        {
            float* hs = (float*)smem;
            float* ys = hs + 46 * 384;
#pragma unroll 1
            for (int sb = 0; sb < 8; ++sb) {
                const int ts = t0 + sb * 16;
                for (int idx = tid; idx < 46 * 384; idx += 256) {
                    const int r = idx / 384, c = idx - r * 384, t = ts - 30 + r;
                    float v = 0.f;
                    if (t >= 0) { const bf16_t* zr = Z + (rb + t) * DIN; v = bf2f(zr[c]) * sigm(bf2f(zr[384 + c])); }
                    hs[idx] = v;
                }
                __syncthreads();
                const int pg = tid >> 7, cl = tid & 127;
#pragma unroll 1
                for (int k = 0; k < 3; ++k) {
                    const int c = cl + 128 * k;
                    float w[31];
#pragma unroll
                    for (int j = 0; j < 31; ++j) w[j] = conv_w[j * 384 + c];
                    float acc[8];
                    const float cb = conv_b[c];
#pragma unroll
                    for (int q = 0; q < 8; ++q) acc[q] = cb;
#pragma unroll
                    for (int i = 0; i < 38; ++i) {
                        const float hv = hs[(pg * 8 + i) * 384 + c];
#pragma unroll
                        for (int q = 0; q < 8; ++q) { if (i - q >= 0 && i - q <= 30) acc[q] += w[i - q] * hv; }
                    }
#pragma unroll
                    for (int q = 0; q < 8; ++q) ys[(pg * 8 + q) * 384 + c] = acc[q];
                }
                __syncthreads();
#pragma unroll
                for (int rr = 0; rr < 4; ++rr) {
                    const int r = wave * 4 + rr;
                    float v[6]; float s = 0.f;
#pragma unroll
                    for (int q = 0; q < 6; ++q) { v[q] = ys[r * 384 + lane + 64 * q]; s += v[q]; }
                    const float mean = wsum(s) * (1.f / 384.f);
                    float s2 = 0.f;
#pragma unroll
                    for (int q = 0; q < 6; ++q) { const float d = v[q] - mean; s2 += d * d; }
                    const float rstd = rsqrtf(wsum(s2) * (1.f / 384.f) + 1e-6f);
#pragma unroll
                    for (int q = 0; q < 6; ++q) {
                        const int c = lane + 64 * q;
                        const float y = (v[q] - mean) * rstd * cln_g[c] + cln_b[c];
                        MIX[(rb + ts + r) * D + c] = f2bf(y * sigm(y));
                    }
                }
                __syncthreads();
            }
        }
        {
            float* wsm = (float*)smem;
            float* vs = wsm + 128 * 128;
            float* st = vs + 128 * 96;
#pragma unroll 1
            for (int rr = 0; rr < 32; ++rr) {
                const int r = wave * 32 + rr;
                const bf16_t* zr = Z + (rb + t0 + r) * DIN + 1152;
                float v[6]; float s = 0.f;
#pragma unroll
                for (int q = 0; q < 6; ++q) { v[q] = gelu_t(bf2f(zr[lane + 64 * q])); s += v[q]; }
                const float mean = wsum(s) * (1.f / 384.f);
                float s2 = 0.f;
#pragma unroll
                for (int q = 0; q < 6; ++q) { const float d = v[q] - mean; s2 += d * d; }
                const float rstd = rsqrtf(wsum(s2) * (1.f / 384.f) + 1e-6f);
                if (lane == 0) { st[r] = mean; st[128 + r] = rstd; }
            }
            __syncthreads();
#pragma unroll 1
            for (int h = 0; h < 4; ++h) {
                const float4* wsrc = (const float4*)(sgu_w + (long)h * 128 * 128);
                for (int idx = tid; idx < 128 * 32; idx += 256) ((float4*)wsm)[idx] = wsrc[idx];
                for (int idx = tid; idx < 128 * 96; idx += 256) {
                    const int r = idx / 96, d = idx - r * 96, ch = h * 96 + d;
                    const float v = gelu_t(bf2f(Z[(rb + t0 + r) * DIN + 1152 + ch]));
                    vs[idx] = (v - st[r]) * st[128 + r] * sln_g[ch] + sln_b[ch];
                }
                __syncthreads();
                const int ig = tid >> 5, dl = tid & 31, jmax = ig < 4 ? 64 : 128;
                float acc[16][3];
#pragma unroll
                for (int ii = 0; ii < 16; ++ii) { acc[ii][0] = 0.f; acc[ii][1] = 0.f; acc[ii][2] = 0.f; }
#pragma unroll 1
                for (int j4 = 0; j4 < jmax; j4 += 4) {
                    float vv[4][3];
#pragma unroll
                    for (int q = 0; q < 4; ++q)
#pragma unroll
                        for (int k = 0; k < 3; ++k) vv[q][k] = vs[(j4 + q) * 96 + dl + 32 * k];
#pragma unroll
                    for (int ii = 0; ii < 16; ++ii) {
                        const float4 w4 = *(const float4*)(wsm + (ig * 16 + ii) * 128 + j4);
#pragma unroll
                        for (int k = 0; k < 3; ++k) acc[ii][k] += w4.x * vv[0][k] + w4.y * vv[1][k] + w4.z * vv[2][k] + w4.w * vv[3][k];
                    }
                }
#pragma unroll
                for (int ii = 0; ii < 16; ++ii) {
                    const int i = ig * 16 + ii;
                    const float sb = sgu_b[h * 128 + i];
#pragma unroll
                    for (int k = 0; k < 3; ++k) {
                        const int ch = h * 96 + dl + 32 * k;
                        const float u = gelu_t(bf2f(Z[(rb + t0 + i) * DIN + 768 + ch]));
                        MIX[(rb + t0 + i) * D + 384 + ch] = f2bf(u * (acc[ii][k] + sb));
                    }
                }
                __syncthreads();
            }
        }
        {
            float* ps = (float*)smem;
            const int ch = tid, g = ch >> 6, w = 2 << g, o = tid & 63;
#pragma unroll 1
            for (int sb = 0; sb < 4; ++sb) {
                const int ts = t0 + sb * 32;
#pragma unroll 1
                for (int r = 0; r < 32; ++r) {
                    const int t = ts + r;
                    float s = 0.f;
                    for (int k = 0; k < w; ++k) if (t - k >= 0) s += bf2f(Z[(rb + t - k) * DIN + 1536 + ch]);
                    const float cnt = (float)((t + 1) < w ? (t + 1) : w);
                    ps[r * 256 + ch] = s / cnt - bf2f(Z[(rb + t) * DIN + 1536 + ch]);
                }
                __syncthreads();
                float acc[32];
#pragma unroll
                for (int r = 0; r < 32; ++r) acc[r] = 0.f;
#pragma unroll 1
                for (int i = 0; i < 64; i += 4) {
                    const float w0 = pool_w[g * 4096 + (i + 0) * 64 + o], w1 = pool_w[g * 4096 + (i + 1) * 64 + o];
                    const float w2 = pool_w[g * 4096 + (i + 2) * 64 + o], w3 = pool_w[g * 4096 + (i + 3) * 64 + o];
#pragma unroll
                    for (int r = 0; r < 32; ++r) {
                        const float4 p4 = *(const float4*)(ps + r * 256 + g * 64 + i);
                        acc[r] += p4.x * w0 + p4.y * w1 + p4.z * w2 + p4.w * w3;
                    }
                }
                const float pb = pool_b[ch], sc = pool_scale[ch];
#pragma unroll
                for (int r = 0; r < 32; ++r) MIX[(rb + ts + r) * D + 768 + ch] = f2bf((acc[r] + pb) * sc);
                __syncthreads();
            }
        }
    }
}

struct Params { const float* in[31]; float* out; char* ws; };

constexpr size_t OFF_H = 1ull << 20;
constexpr size_t OFF_Z = OFF_H + (size_t)T * D * 2;
constexpr size_t OFF_MIX = OFF_Z + (size_t)T * DIN * 2;
constexpr size_t OFF_ACT = OFF_MIX + (size_t)T * D * 2;
constexpr size_t OFF_MN = OFF_ACT + (size_t)T * DFF * 2;
constexpr size_t OFF_KB = OFF_MN + (size_t)2048 * D * 2;
constexpr size_t OFF_VB = OFF_KB + (size_t)2048 * D * 2;
constexpr size_t OFF_LIST = OFF_VB + (size_t)2048 * D * 2;
constexpr size_t OFF_GATE = OFF_LIST + (size_t)NE * T * 4;

extern "C" __global__ __launch_bounds__(256) void mega(Params P) {
    extern __shared__ __attribute__((aligned(16))) char smem[];
    __shared__ uint4 xb_words;
    if (threadIdx.x == 0) xb_words = make_uint4(0u, 0u, 0u, 0u);
    __syncthreads();
    unsigned* bar = (unsigned*)P.ws;
    XcdBarrier xb = xcd_barrier_post(bar, (volatile LAS unsigned*)&xb_words);
    int* cnt = (int*)(P.ws + 16384);
    bf16_t* H = (bf16_t*)(P.ws + OFF_H);
    bf16_t* Z = (bf16_t*)(P.ws + OFF_Z);
    bf16_t* MIX = (bf16_t*)(P.ws + OFF_MIX);
    bf16_t* ACT = (bf16_t*)(P.ws + OFF_ACT);
    float* SC = (float*)(P.ws + OFF_ACT);
    bf16_t* Q = Z; bf16_t* PB = MIX; bf16_t* O = H;
    bf16_t* MN = (bf16_t*)(P.ws + OFF_MN);
    bf16_t* KB = (bf16_t*)(P.ws + OFF_KB);
    bf16_t* VB = (bf16_t*)(P.ws + OFF_VB);
    int* list = (int*)(P.ws + OFF_LIST);
    float* gatev = (float*)(P.ws + OFF_GATE);
    float* X = P.out;

    for (int l = 0; l < 2; ++l) {
        const float* Xsrc = (l == 0) ? P.in[0] : X;
        rmsnorm_phase<false, false>(Xsrc, P.in[2] + l * D, H, T, nullptr, nullptr, nullptr, nullptr);
        xcd_barrier(xb);
        { GemmP g{}; g.A = H; g.lda = D; g.B = P.in[3] + (long)l * D * DIN; g.ldb = DIN; g.M = T; g.N = DIN; g.K = D; g.nbatch = 1; g.C = Z; g.ldc = DIN;
          gemm<0, 0, false>(g, smem); }
        xcd_barrier(xb);
        mixer_phase(Z, MIX, smem, P.in[4] + l * 31 * 384, P.in[5] + l * 384, P.in[6] + l * 384, P.in[7] + l * 384,
                    P.in[8] + l * 384, P.in[9] + l * 384, P.in[10] + (long)l * 4 * 128 * 128, P.in[11] + l * 4 * 128,
                    P.in[12] + l * 4 * 64 * 64, P.in[13] + l * 256, P.in[14] + l * 256);
        xcd_barrier(xb);
        { GemmP g{}; g.A = MIX; g.lda = D; g.B = P.in[15] + (long)l * D * D; g.ldb = D; g.M = T; g.N = D; g.K = D; g.nbatch = 1; g.C = X; g.ldc = D; g.R = Xsrc;
          gemm<0, 2, false>(g, smem); }
        xcd_barrier(xb);
        rmsnorm_phase<false, false>(X, P.in[16] + l * D, H, T, nullptr, nullptr, nullptr, nullptr);
        rmsnorm_phase<false, false>(P.in[1], P.in[17] + l * D, MN, 2048, nullptr, nullptr, nullptr, nullptr);
        xcd_barrier(xb);
        { GemmP g{}; g.A = H; g.lda = D; g.B = P.in[18] + (long)l * D * D; g.ldb = D; g.M = T; g.N = D; g.K = D; g.nbatch = 1; g.C = Q; g.ldc = D;
          gemm<0, 0, false>(g, smem);
          g.A = MN; g.M = 2048; g.B = P.in[19] + (long)l * D * D; g.C = KB; gemm<0, 0, false>(g, smem);
          g.B = P.in[20] + (long)l * D * D; g.C = VB; gemm<0, 0, false>(g, smem); }
        xcd_barrier(xb);
        { GemmP g{}; g.A = Q; g.lda = D; g.B = KB; g.ldb = D; g.M = S; g.N = 256; g.K = 256; g.nbatch = 32;
          g.aB1 = (long)S * D; g.aB2 = 256; g.bB1 = 256L * D; g.bB2 = 256; g.cB1 = (long)S * D; g.cB2 = 256; g.C = SC; g.ldc = D; g.scale = 0.0625f;
          gemm<1, 1, false>(g, smem); }
        xcd_barrier(xb);
        softmax_phase(SC, PB);
        xcd_barrier(xb);
        { GemmP g{}; g.A = PB; g.lda = D; g.B = VB; g.ldb = D; g.M = S; g.N = 256; g.K = 256; g.nbatch = 32;
          g.aB1 = (long)S * D; g.aB2 = 256; g.bB1 = 256L * D; g.bB2 = 256; g.cB1 = (long)S * D; g.cB2 = 256; g.C = O; g.ldc = D;
          gemm<2, 0, false>(g, smem); }
        xcd_barrier(xb);
        { GemmP g{}; g.A = O; g.lda = D; g.B = P.in[21] + (long)l * D * D; g.ldb = D; g.M = T; g.N = D; g.K = D; g.nbatch = 1; g.C = X; g.ldc = D; g.R = X;
          gemm<0, 2, false>(g, smem); }
        xcd_barrier(xb);
        if (l == 0) rmsnorm_phase<false, false>(X, P.in[22] + l * D, H, T, nullptr, nullptr, nullptr, nullptr);
        else rmsnorm_phase<false, true>(X, P.in[22] + l * D, H, T, P.in[26], cnt, list, gatev);
        xcd_barrier(xb);
        if (l == 0) {
            { GemmP g{}; g.A = H; g.lda = D; g.B = P.in[23]; g.B2 = P.in[24]; g.ldb = DFF; g.M = T; g.N = DFF; g.K = D; g.nbatch = 1; g.C = ACT; g.ldc = DFF;
              gemm<0, 3, true>(g, smem); }
            xcd_barrier(xb);
            { GemmP g{}; g.A = ACT; g.lda = DFF; g.B = P.in[25]; g.ldb = D; g.M = T; g.N = D; g.K = DFF; g.nbatch = 1; g.C = X; g.ldc = D; g.R = X;
              gemm<0, 2, false>(g, smem); }
            xcd_barrier(xb);
        } else {
            for (int e = 0; e < NE; ++e) {
                const int Me = __hip_atomic_load(&cnt[e], __ATOMIC_RELAXED, __HIP_MEMORY_SCOPE_AGENT);
                { GemmP g{}; g.A = H; g.lda = D; g.gatherA = list + e * T; g.B = P.in[27] + (long)e * D * DFF; g.B2 = P.in[28] + (long)e * D * DFF; g.ldb = DFF;
                  g.M = Me; g.N = DFF; g.K = D; g.nbatch = 1; g.C = ACT; g.ldc = DFF;
                  if (Me > 0) gemm<0, 3, true>(g, smem); }
                xcd_barrier(xb);
                { GemmP g{}; g.A = ACT; g.lda = DFF; g.B = P.in[29] + (long)e * DFF * D; g.ldb = D; g.M = Me; g.N = D; g.K = DFF; g.nbatch = 1; g.C = X; g.ldc = D;
                  g.scatter = list + e * T; g.gate = gatev + e * T;
                  if (Me > 0) gemm<0, 4, false>(g, smem); }
                xcd_barrier(xb);
            }
        }
    }
    rmsnorm_phase<true, false>(X, P.in[30], X, T, nullptr, nullptr, nullptr, nullptr);
}

extern "C" void kernel_launch(void* const* d_in, const int* in_sizes, int n_in,
                              void* d_out, int out_size, void* d_ws, size_t ws_size,
                              hipStream_t stream) {
    Params p{};
    for (int i = 0; i < 31; ++i) p.in[i] = (const float*)d_in[i];
    p.out = (float*)d_out; p.ws = (char*)d_ws;
    hipFuncSetAttribute((const void*)mega, hipFuncAttributeMaxDynamicSharedMemorySize, LDS_BYTES);
    int dev = 0; hipGetDevice(&dev);
    int ncu = 256; hipDeviceGetAttribute(&ncu, hipDeviceAttributeMultiprocessorCount, dev);
    int per_cu = 0;
    if (hipOccupancyMaxActiveBlocksPerMultiprocessor(&per_cu, (const void*)mega, 256, LDS_BYTES) != hipSuccess || per_cu < 1) return;
    const int grid = ncu;
    hipMemsetAsync(d_ws, 0, 32768, stream);
    hipLaunchKernelGGL(mega, dim3(grid), dim3(256), LDS_BYTES, stream, p);
}
```

```cpp
#include <hip/hip_runtime.h>
#include <stdint.h>

#define XB_TMO      128
#define XB_XCNT(j)  (256  + 64 * (j))
#define XB_XSUB(j)  (1280 + 64 * (j))
#define XB_XGEN(j)  (2304 + 64 * (j))
#define XB_TOP      3328
#define XB_TOPGEN   3392
#define XCD_BAR_WORDS 3456
#define XB_SPIN_CAP (1u << 22)
#define LAS __attribute__((address_space(3)))

__device__ __forceinline__ unsigned xb_ld(unsigned* p)              { return __hip_atomic_load(p, __ATOMIC_RELAXED, __HIP_MEMORY_SCOPE_AGENT); }
__device__ __forceinline__ unsigned xb_add(unsigned* p, unsigned v) { return __hip_atomic_fetch_add(p, v, __ATOMIC_RELAXED, __HIP_MEMORY_SCOPE_AGENT); }
__device__ __forceinline__ unsigned xb_xcc_id() { return (unsigned)__builtin_amdgcn_s_getreg((3 << 11) | 20) & 0xFu; }
#define XB_SPIN(cond, bar) do { unsigned _sp = 0; while (cond) { __builtin_amdgcn_s_sleep(1); \
    if ((++_sp & 255u) == 0u) { if (xb_ld(&(bar)[XB_TMO])) break; if (_sp > XB_SPIN_CAP) { atomicAdd(&(bar)[XB_TMO], 1u); break; } } } } while (0)

struct XcdBarrier { unsigned* bar; unsigned x; volatile LAS unsigned* st; };

__device__ __forceinline__ XcdBarrier xcd_barrier_post(unsigned* bar, volatile LAS unsigned* st) {
    XcdBarrier b; b.bar = bar; b.x = xb_xcc_id(); b.st = st;
    if (threadIdx.x == 0) (void)xb_add(&bar[XB_XCNT(b.x)], 1u);
    return b;
}
__device__ __forceinline__ void xcd_barrier_complete(unsigned* bar, unsigned x, unsigned& nloc, unsigned& nx) {
    const unsigned G = gridDim.x * gridDim.y * gridDim.z;
    unsigned sum, cnt, mine, sp = 0u;
    for (;;) {
        sum = 0u; cnt = 0u; mine = 0u;
#pragma unroll
        for (unsigned j = 0; j < 16; ++j) { const unsigned c = xb_ld(&bar[XB_XCNT(j)]); sum += c; cnt += (c > 0u) ? 1u : 0u; mine = (j == x) ? c : mine; }
        if (sum == G) break;
        __builtin_amdgcn_s_sleep(1);
        if ((++sp & 255u) == 0u) { if (xb_ld(&bar[XB_TMO])) break; if (sp > XB_SPIN_CAP) { atomicAdd(&bar[XB_TMO], 1u); break; } }
    }
    nloc = mine > 0u ? mine : 1u; nx = cnt > 0u ? cnt : 1u;
}
__device__ __forceinline__ void xcd_barrier(const XcdBarrier& b) {
    asm volatile("s_waitcnt vmcnt(0)" ::: "memory");
    __syncthreads();
    if (threadIdx.x == 0) {
        unsigned* bar = b.bar;
        __builtin_amdgcn_s_waitcnt(0);
        unsigned nloc = b.st[0], nx = b.st[1];
        if (nloc == 0u) { xcd_barrier_complete(bar, b.x, nloc, nx); b.st[0] = nloc; b.st[1] = nx; }
        const unsigned old = xb_add(&bar[XB_XSUB(b.x)], 1u);
        const unsigned gen = old / nloc;
        if (old + 1u == (gen + 1u) * nloc) {
            __builtin_amdgcn_fence(__ATOMIC_RELEASE, "agent");
            asm volatile("s_waitcnt vmcnt(0)" ::: "memory");
            const unsigned og = xb_add(&bar[XB_TOP], 1u);
            const unsigned tg = og / nx;
            if (og + 1u == (tg + 1u) * nx) xb_add(&bar[XB_TOPGEN], 1u);
            else XB_SPIN(xb_ld(&bar[XB_TOPGEN]) == tg, bar);
            __builtin_amdgcn_fence(__ATOMIC_ACQUIRE, "agent");
            xb_add(&bar[XB_XGEN(b.x)], 1u);
            asm volatile("s_waitcnt vmcnt(0)" ::: "memory");
        } else {
            XB_SPIN(xb_ld(&bar[XB_XGEN(b.x)]) == gen, bar);
            __builtin_amdgcn_fence(__ATOMIC_ACQUIRE, "agent");
            asm volatile("s_waitcnt vmcnt(0)" ::: "memory");
        }
    }
    __syncthreads();
}

typedef unsigned short bf16_t;
typedef short s16x4 __attribute__((ext_vector_type(4)));
typedef float f32x16 __attribute__((ext_vector_type(16)));

__device__ __forceinline__ bf16_t f2bf(float f) { unsigned u = __float_as_uint(f); u += 0x7fffu + ((u >> 16) & 1u); return (bf16_t)(u >> 16); }
__device__ __forceinline__ float bf2f(bf16_t h) { return __uint_as_float(((unsigned)h) << 16); }
__device__ __forceinline__ unsigned pack2(float a, float b) { return (unsigned)f2bf(a) | ((unsigned)f2bf(b) << 16); }
__device__ __forceinline__ float wsum(float v) {
#pragma unroll
    for (int o = 32; o > 0; o >>= 1) v += __shfl_xor(v, o, 64);
    return v;
}
__device__ __forceinline__ float wmax(float v) {
#pragma unroll
    for (int o = 32; o > 0; o >>= 1) v = fmaxf(v, __shfl_xor(v, o, 64));
    return v;
}
__device__ __forceinline__ float gelu_t(float x) { return 0.5f * x * (1.f + tanhf(0.7978845608028654f * (x + 0.044715f * x * x * x))); }
__device__ __forceinline__ float sigm(float x) { return 1.f / (1.f + __expf(-x)); }

constexpr int T = 32768, D = 1024, S = 4096, DIN = 1792, DFF = 2816, NE = 8;
constexpr int LDS_BYTES = 65536 + 49152 + 1024;

struct GemmP {
    const bf16_t* A; long lda; const int* gatherA;
    const void* B; const void* B2; long ldb;
    int M, N, K, nbatch;
    long aB1, aB2, bB1, bB2, cB1, cB2;
    void* C; long ldc; const float* R; float scale; const int* scatter; const float* gate;
};
template <int BMODE, int EPI, bool DUAL>
__device__ __forceinline__ void gemm(const GemmP& p, char* smem) {
    constexpr int LS = 72;
    bf16_t* sA = (bf16_t*)smem;
    bf16_t* sB = sA + 128 * LS;
    int tid = threadIdx.x; asm volatile("" : "+v"(tid));
    const int lane = tid & 63, wave = tid >> 6, wr = wave >> 1, wc = wave & 1;
    const int mt = (p.M + 127) >> 7, nt = p.N >> 7, per = mt * nt, total = per * p.nbatch, nk = p.K >> 6;
    for (int tile = blockIdx.x; tile < total; tile += gridDim.x) {
        const int batch = tile / per, rem = tile - batch * per, tm = rem / nt, tn = rem - tm * nt;
        const long aoff = (long)(batch >> 2) * p.aB1 + (long)(batch & 3) * p.aB2;
        const long boff = (long)(batch >> 2) * p.bB1 + (long)(batch & 3) * p.bB2;
        const long coff = (long)(batch >> 2) * p.cB1 + (long)(batch & 3) * p.cB2;
        const bf16_t *arow0, *arow1, *arow2, *arow3;
        {
            int r0 = tm * 128 + (tid >> 3), r1 = r0 + 32, r2 = r0 + 64, r3 = r0 + 96;
            if (r0 >= p.M) r0 = p.M - 1; if (r1 >= p.M) r1 = p.M - 1; if (r2 >= p.M) r2 = p.M - 1; if (r3 >= p.M) r3 = p.M - 1;
            const long s0 = p.gatherA ? (long)p.gatherA[r0] : (long)r0, s1 = p.gatherA ? (long)p.gatherA[r1] : (long)r1;
            const long s2 = p.gatherA ? (long)p.gatherA[r2] : (long)r2, s3 = p.gatherA ? (long)p.gatherA[r3] : (long)r3;
            const bf16_t* ab = p.A + aoff + (tid & 7) * 8;
            arow0 = ab + s0 * p.lda; arow1 = ab + s1 * p.lda; arow2 = ab + s2 * p.lda; arow3 = ab + s3 * p.lda;
        }
        uint4 ar0, ar1, ar2, ar3;
        float bfv[DUAL ? 64 : 32];
        unsigned bu[32];
        const int bn = tid & 127, bkh = tid >> 7;
        auto loadg = [&](int kt) {
            const int k0 = kt * 64;
            ar0 = *(const uint4*)(arow0 + k0); ar1 = *(const uint4*)(arow1 + k0); ar2 = *(const uint4*)(arow2 + k0); ar3 = *(const uint4*)(arow3 + k0);
            if constexpr (BMODE == 0) {
                const float* Bp = (const float*)p.B + boff + tn * 128 + bn;
#pragma unroll
                for (int j = 0; j < 8; ++j)
#pragma unroll
                    for (int q = 0; q < 4; ++q) bfv[j * 4 + q] = Bp[(long)(k0 + (bkh + 2 * j) * 4 + q) * p.ldb];
                if constexpr (DUAL) {
                    const float* Bq = (const float*)p.B2 + boff + tn * 128 + bn;
#pragma unroll
                    for (int j = 0; j < 8; ++j)
#pragma unroll
                        for (int q = 0; q < 4; ++q) bfv[32 + j * 4 + q] = Bq[(long)(k0 + (bkh + 2 * j) * 4 + q) * p.ldb];
                }
            } else if constexpr (BMODE == 1) {
                const bf16_t* Bp = (const bf16_t*)p.B + boff + (long)(tn * 128 + (tid >> 1)) * p.ldb + k0 + (tid & 1) * 32;
#pragma unroll
                for (int j = 0; j < 4; ++j) { const uint4 v = *(const uint4*)(Bp + j * 8); bu[j * 4] = v.x; bu[j * 4 + 1] = v.y; bu[j * 4 + 2] = v.z; bu[j * 4 + 3] = v.w; }
            } else {
                const bf16_t* Bp = (const bf16_t*)p.B + boff + tn * 128 + bn;
#pragma unroll
                for (int j = 0; j < 8; ++j)
#pragma unroll
                    for (int q = 0; q < 4; ++q) bu[j * 4 + q] = Bp[(long)(k0 + (bkh + 2 * j) * 4 + q) * p.ldb];
            }
        };
        auto stores = [&]() {
            bf16_t* da = sA + (tid >> 3) * LS + (tid & 7) * 8;
            *(uint4*)da = ar0; *(uint4*)(da + 32 * LS) = ar1; *(uint4*)(da + 64 * LS) = ar2; *(uint4*)(da + 96 * LS) = ar3;
            if constexpr (BMODE == 0) {
#pragma unroll
                for (int j = 0; j < 8; ++j) {
                    uint2 v; v.x = pack2(bfv[j * 4], bfv[j * 4 + 1]); v.y = pack2(bfv[j * 4 + 2], bfv[j * 4 + 3]);
                    *(uint2*)(sB + bn * LS + (bkh + 2 * j) * 4) = v;
                    if constexpr (DUAL) {
                        uint2 w; w.x = pack2(bfv[32 + j * 4], bfv[32 + j * 4 + 1]); w.y = pack2(bfv[32 + j * 4 + 2], bfv[32 + j * 4 + 3]);
                        *(uint2*)(sB + (128 + bn) * LS + (bkh + 2 * j) * 4) = w;
                    }
                }
            } else if constexpr (BMODE == 1) {
                bf16_t* d = sB + (tid >> 1) * LS + (tid & 1) * 32;
#pragma unroll
                for (int j = 0; j < 4; ++j) { uint4 v; v.x = bu[j * 4]; v.y = bu[j * 4 + 1]; v.z = bu[j * 4 + 2]; v.w = bu[j * 4 + 3]; *(uint4*)(d + j * 8) = v; }
            } else {
#pragma unroll
                for (int j = 0; j < 8; ++j) {
                    uint2 v; v.x = bu[j * 4] | (bu[j * 4 + 1] << 16); v.y = bu[j * 4 + 2] | (bu[j * 4 + 3] << 16);
                    *(uint2*)(sB + bn * LS + (bkh + 2 * j) * 4) = v;
                }
            }
        };
        f32x16 acc[2][2], acc2[2][2];
#pragma unroll
        for (int a = 0; a < 2; ++a)
#pragma unroll
            for (int b = 0; b < 2; ++b)
#pragma unroll
                for (int i = 0; i < 16; ++i) { acc[a][b][i] = 0.f; acc2[a][b][i] = 0.f; }
        loadg(0);
#pragma unroll 1
        for (int kt = 0; kt < nk; ++kt) {
            __syncthreads();
            stores();
            __syncthreads();
            if (kt + 1 < nk) loadg(kt + 1);
#pragma unroll
            for (int ks = 0; ks < 8; ++ks) {
                const int kk = ks * 8 + (lane >> 5) * 4;
                s16x4 af[2], bfr[2], bf2[2];
#pragma unroll
                for (int mi = 0; mi < 2; ++mi) af[mi] = *(const s16x4*)(sA + (wr * 64 + mi * 32 + (lane & 31)) * LS + kk);
#pragma unroll
                for (int ni = 0; ni < 2; ++ni) {
                    bfr[ni] = *(const s16x4*)(sB + (wc * 64 + ni * 32 + (lane & 31)) * LS + kk);
                    if constexpr (DUAL) bf2[ni] = *(const s16x4*)(sB + (128 + wc * 64 + ni * 32 + (lane & 31)) * LS + kk);
                }
#pragma unroll
                for (int mi = 0; mi < 2; ++mi)
#pragma unroll
                    for (int ni = 0; ni < 2; ++ni) {
                        acc[mi][ni] = __builtin_amdgcn_mfma_f32_32x32x8bf16_1k(af[mi], bfr[ni], acc[mi][ni], 0, 0, 0);
                        if constexpr (DUAL) acc2[mi][ni] = __builtin_amdgcn_mfma_f32_32x32x8bf16_1k(af[mi], bf2[ni], acc2[mi][ni], 0, 0, 0);
                    }
            }
        }
#pragma unroll
        for (int mi = 0; mi < 2; ++mi)
#pragma unroll
            for (int ni = 0; ni < 2; ++ni)
#pragma unroll
                for (int i = 0; i < 16; ++i) {
                    const int r = tm * 128 + wr * 64 + mi * 32 + (i >> 2) * 8 + (lane >> 5) * 4 + (i & 3);
                    const int c = tn * 128 + wc * 64 + ni * 32 + (lane & 31);
                    if (r < p.M) {
                        const float v = acc[mi][ni][i];
                        const long idx = coff + (long)r * p.ldc + c;
                        if constexpr (EPI == 0) ((bf16_t*)p.C)[idx] = f2bf(v);
                        else if constexpr (EPI == 1) ((float*)p.C)[idx] = v * p.scale;
                        else if constexpr (EPI == 2) ((float*)p.C)[idx] = p.R[idx] + v;
                        else if constexpr (EPI == 3) { const float u = acc2[mi][ni][i]; ((bf16_t*)p.C)[idx] = f2bf(v * sigm(v) * u); }
                        else { const long tk = p.scatter[r]; float* x = (float*)p.C + tk * p.ldc + c; *x = *x + p.gate[r] * v; }
                    }
                }
    }
}

template <bool OUTF, bool ROUTER>
__device__ __forceinline__ void rmsnorm_phase(const float* X, const float* g, void* out, int rows,
                                              const float* rw, int* cnt, int* list, float* gatev) {
    int tid = threadIdx.x; asm volatile("" : "+v"(tid));
    const int lane = tid & 63, wave = tid >> 6;
    for (int row = blockIdx.x * 4 + wave; row < rows; row += gridDim.x * 4) {
        const float* xr = X + (long)row * D;
        float4 v[4]; float ss = 0.f;
#pragma unroll
        for (int j = 0; j < 4; ++j) { v[j] = *(const float4*)(xr + (j * 64 + lane) * 4); ss += v[j].x * v[j].x + v[j].y * v[j].y + v[j].z * v[j].z + v[j].w * v[j].w; }
        ss = wsum(ss);
        const float rs = rsqrtf(ss * (1.f / D) + 1e-6f);
        float lg[NE];
        if constexpr (ROUTER) {
#pragma unroll
            for (int e = 0; e < NE; ++e) lg[e] = 0.f;
        }
#pragma unroll
        for (int j = 0; j < 4; ++j) {
            const int c = (j * 64 + lane) * 4;
            const float4 gg = *(const float4*)(g + c);
            float4 y; y.x = v[j].x * rs * gg.x; y.y = v[j].y * rs * gg.y; y.z = v[j].z * rs * gg.z; y.w = v[j].w * rs * gg.w;
            if constexpr (OUTF) *(float4*)((float*)out + (long)row * D + c) = y;
            else { uint2 pk; pk.x = pack2(y.x, y.y); pk.y = pack2(y.z, y.w); *(uint2*)((bf16_t*)out + (long)row * D + c) = pk; }
            if constexpr (ROUTER) {
                const float4 r0 = *(const float4*)(rw + (long)c * NE), r1 = *(const float4*)(rw + (long)c * NE + 4);
                const float4 r2 = *(const float4*)(rw + (long)(c + 1) * NE), r3 = *(const float4*)(rw + (long)(c + 1) * NE + 4);
                const float4 r4 = *(const float4*)(rw + (long)(c + 2) * NE), r5 = *(const float4*)(rw + (long)(c + 2) * NE + 4);
                const float4 r6 = *(const float4*)(rw + (long)(c + 3) * NE), r7 = *(const float4*)(rw + (long)(c + 3) * NE + 4);
                lg[0] += y.x * r0.x + y.y * r2.x + y.z * r4.x + y.w * r6.x; lg[1] += y.x * r0.y + y.y * r2.y + y.z * r4.y + y.w * r6.y;
                lg[2] += y.x * r0.z + y.y * r2.z + y.z * r4.z + y.w * r6.z; lg[3] += y.x * r0.w + y.y * r2.w + y.z * r4.w + y.w * r6.w;
                lg[4] += y.x * r1.x + y.y * r3.x + y.z * r5.x + y.w * r7.x; lg[5] += y.x * r1.y + y.y * r3.y + y.z * r5.y + y.w * r7.y;
                lg[6] += y.x * r1.z + y.y * r3.z + y.z * r5.z + y.w * r7.z; lg[7] += y.x * r1.w + y.y * r3.w + y.z * r5.w + y.w * r7.w;
            }
        }
        if constexpr (ROUTER) {
#pragma unroll
            for (int e = 0; e < NE; ++e) lg[e] = wsum(lg[e]);
            if (lane == 0) {
                int i0 = 0; float v0 = lg[0];
#pragma unroll
                for (int e = 1; e < NE; ++e) if (lg[e] > v0) { v0 = lg[e]; i0 = e; }
                int i1 = -1; float v1 = -3.0e38f;
#pragma unroll
                for (int e = 0; e < NE; ++e) if (e != i0 && lg[e] > v1) { v1 = lg[e]; i1 = e; }
                const float e1 = __expf(v1 - v0), g0 = 1.f / (1.f + e1), g1 = e1 / (1.f + e1);
                const int s0 = atomicAdd(&cnt[i0], 1); list[i0 * T + s0] = row; gatev[i0 * T + s0] = g0;
                const int s1 = atomicAdd(&cnt[i1], 1); list[i1 * T + s1] = row; gatev[i1 * T + s1] = g1;
            }
        }
    }
}

__device__ __forceinline__ void softmax_phase(const float* Sc, bf16_t* P) {
    int tid = threadIdx.x; asm volatile("" : "+v"(tid));
    const int lane = tid & 63, wave = tid >> 6;
    for (int it = blockIdx.x * 4 + wave; it < T * 4; it += gridDim.x * 4) {
        const float4 v = *(const float4*)(Sc + (long)it * 256 + lane * 4);
        const float m = wmax(fmaxf(fmaxf(v.x, v.y), fmaxf(v.z, v.w)));
        const float e0 = __expf(v.x - m), e1 = __expf(v.y - m), e2 = __expf(v.z - m), e3 = __expf(v.w - m);
        const float inv = 1.f / wsum(e0 + e1 + e2 + e3);
        uint2 pk; pk.x = pack2(e0 * inv, e1 * inv); pk.y = pack2(e2 * inv, e3 * inv);
        *(uint2*)(P + (long)it * 256 + lane * 4) = pk;
    }
}

__device__ __forceinline__ void mixer_phase(const bf16_t* Z, bf16_t* MIX, char* smem,
        const float* conv_w, const float* conv_b, const float* cln_g, const float* cln_b,
        const float* sln_g, const float* sln_b, const float* sgu_w, const float* sgu_b,
        const float* pool_w, const float* pool_b, const float* pool_scale) {
    int tid = threadIdx.x; asm volatile("" : "+v"(tid));
    const int lane = tid & 63, wave = tid >> 6;
    for (int unit = blockIdx.x; unit < 256; unit += gridDim.x) {
        const int b = unit >> 5, t0 = (unit & 31) * 128;
        const long rb = (long)b * S;
        {
            float* hs = (float*)smem;
            float* ys = hs + 46 * 384;
#pragma unroll 1
            for (int sb = 0; sb < 8; ++sb) {
                const int ts = t0 + sb * 16;
                for (int idx = tid; idx < 46 * 384; idx += 256) {
                    const int r = idx / 384, c = idx - r * 384, t = ts - 30 + r;
                    float v = 0.f;
                    if (t >= 0) { const bf16_t* zr = Z + (rb + t) * DIN; v = bf2f(zr[c]) * sigm(bf2f(zr[384 + c])); }
                    hs[idx] = v;
                }
                __syncthreads();
                const int pg = tid >> 7, cl = tid & 127;
#pragma unroll 1
                for (int k = 0; k < 3; ++k) {
                    const int c = cl + 128 * k;
                    float w[31];
#pragma unroll
                    for (int j = 0; j < 31; ++j) w[j] = conv_w[j * 384 + c];
                    float acc[8];
                    const float cb = conv_b[c];
#pragma unroll
                    for (int q = 0; q < 8; ++q) acc[q] = cb;
#pragma unroll
                    for (int i = 0; i < 38; ++i) {
                        const float hv = hs[(pg * 8 + i) * 384 + c];
#pragma unroll
                        for (int q = 0; q < 8; ++q) { if (i - q >= 0 && i - q <= 30) acc[q] += w[i - q] * hv; }
                    }
#pragma unroll
                    for (int q = 0; q < 8; ++q) ys[(pg * 8 + q) * 384 + c] = acc[q];
                }
                __syncthreads();
#pragma unroll
                for (int rr = 0; rr < 4; ++rr) {
                    const int r = wave * 4 + rr;
                    float v[6]; float s = 0.f;
#pragma unroll
                    for (int q = 0; q < 6; ++q) { v[q] = ys[r * 384 + lane + 64 * q]; s += v[q]; }
                    const float mean = wsum(s) * (1.f / 384.f);
                    float s2 = 0.f;
#pragma unroll
                    for (int q = 0; q < 6; ++q) { const float d = v[q] - mean; s2 += d * d; }
                    const float rstd = rsqrtf(wsum(s2) * (1.f / 384.f) + 1e-6f);
#pragma unroll
                    for (int q = 0; q < 6; ++q) {
                        const int c = lane + 64 * q;
                        const float y = (v[q] - mean) * rstd * cln_g[c] + cln_b[c];
                        MIX[(rb + ts + r) * D + c] = f2bf(y * sigm(y));
                    }
                }
                __syncthreads();
            }
        }
        {
            float* wsm = (float*)smem;
            float* vs = wsm + 128 * 128;
            float* st = vs + 128 * 96;
#pragma unroll 1
            for (int rr = 0; rr < 32; ++rr) {
                const int r = wave * 32 + rr;
                const bf16_t* zr = Z + (rb + t0 + r) * DIN + 1152;
                float v[6]; float s = 0.f;
#pragma unroll
                for (int q = 0; q < 6; ++q) { v[q] = gelu_t(bf2f(zr[lane + 64 * q])); s += v[q]; }
                const float mean = wsum(s) * (1.f / 384.f);
                float s2 = 0.f;
#pragma unroll
                for (int q = 0; q < 6; ++q) { const float d = v[q] - mean; s2 += d * d; }
                const float rstd = rsqrtf(wsum(s2) * (1.f / 384.f) + 1e-6f);
                if (lane == 0) { st[r] = mean; st[128 + r] = rstd; }
            }
            __syncthreads();
#pragma unroll 1
            for (int h = 0; h < 4; ++h) {
                const float4* wsrc = (const float4*)(sgu_w + (long)h * 128 * 128);
                for (int idx = tid; idx < 128 * 32; idx += 256) ((float4*)wsm)[idx] = wsrc[idx];
                for (int idx = tid; idx < 128 * 96; idx += 256) {
                    const int r = idx / 96, d = idx - r * 96, ch = h * 96 + d;
                    const float v = gelu_t(bf2f(Z[(rb + t0 + r) * DIN + 1152 + ch]));
                    vs[idx] = (v - st[r]) * st[128 + r] * sln_g[ch] + sln_b[ch];
                }
                __syncthreads();
                const int ig = tid >> 5, dl = tid & 31, jmax = ig < 4 ? 64 : 128;
                float acc[16][3];
#pragma unroll
                for (int ii = 0; ii < 16; ++ii) { acc[ii][0] = 0.f; acc[ii][1] = 0.f; acc[ii][2] = 0.f; }
#pragma unroll 1
                for (int j4 = 0; j4 < jmax; j4 += 4) {
                    float vv[4][3];
#pragma unroll
                    for (int q = 0; q < 4; ++q)
#pragma unroll
                        for (int k = 0; k < 3; ++k) vv[q][k] = vs[(j4 + q) * 96 + dl + 32 * k];
#pragma unroll
                    for (int ii = 0; ii < 16; ++ii) {
                        const float4 w4 = *(const float4*)(wsm + (ig * 16 + ii) * 128 + j4);
#pragma unroll
                        for (int k = 0; k < 3; ++k) acc[ii][k] += w4.x * vv[0][k] + w4.y * vv[1][k] + w4.z * vv[2][k] + w4.w * vv[3][k];
                    }
                }
#pragma unroll
                for (int ii = 0; ii < 16; ++ii) {
                    const int i = ig * 16 + ii;
                    const float sb = sgu_b[h * 128 + i];
#pragma unroll
                    for (int k = 0; k < 3; ++k) {
                        const int ch = h * 96 + dl + 32 * k;
                        const float u = gelu_t(bf2f(Z[(rb + t0 + i) * DIN + 768 + ch]));
                        MIX[(rb + t0 + i) * D + 384 + ch] = f2bf(u * (acc[ii][k] + sb));
                    }
                }
                __syncthreads();
            }
        }
        {
            float* ps = (float*)smem;
            const int ch = tid, g = ch >> 6, w = 2 << g, o = tid & 63;
#pragma unroll 1
            for (int sb = 0; sb < 4; ++sb) {
                const int ts = t0 + sb * 32;
#pragma unroll 1
                for (int r = 0; r < 32; ++r) {
                    const int t = ts + r;
                    float s = 0.f;
                    for (int k = 0; k < w; ++k) if (t - k >= 0) s += bf2f(Z[(rb + t - k) * DIN + 1536 + ch]);
                    const float cnt = (float)((t + 1) < w ? (t + 1) : w);
                    ps[r * 256 + ch] = s / cnt - bf2f(Z[(rb + t) * DIN + 1536 + ch]);
                }
                __syncthreads();
                float acc[32];
#pragma unroll
                for (int r = 0; r < 32; ++r) acc[r] = 0.f;
#pragma unroll 1
                for (int i = 0; i < 64; i += 4) {
                    const float w0 = pool_w[g * 4096 + (i + 0) * 64 + o], w1 = pool_w[g * 4096 + (i + 1) * 64 + o];
                    const float w2 = pool_w[g * 4096 + (i + 2) * 64 + o], w3 = pool_w[g * 4096 + (i + 3) * 64 + o];
#pragma unroll
                    for (int r = 0; r < 32; ++r) {
                        const float4 p4 = *(const float4*)(ps + r * 256 + g * 64 + i);
                        acc[r] += p4.x * w0 + p4.y * w1 + p4.z * w2 + p4.w * w3;
                    }
                }
                const float pb = pool_b[ch], sc = pool_scale[ch];
#pragma unroll
                for (int r = 0; r < 32; ++r) MIX[(rb + ts + r) * D + 768 + ch] = f2bf((acc[r] + pb) * sc);
                __syncthreads();
            }
        }
    }
}

struct Params { const float* in[31]; float* out; char* ws; };

constexpr size_t OFF_H = 1ull << 20;
constexpr size_t OFF_Z = OFF_H + (size_t)T * D * 2;
constexpr size_t OFF_MIX = OFF_Z + (size_t)T * DIN * 2;
constexpr size_t OFF_ACT = OFF_MIX + (size_t)T * D * 2;
constexpr size_t OFF_MN = OFF_ACT + (size_t)T * DFF * 2;
constexpr size_t OFF_KB = OFF_MN + (size_t)2048 * D * 2;
constexpr size_t OFF_VB = OFF_KB + (size_t)2048 * D * 2;
constexpr size_t OFF_LIST = OFF_VB + (size_t)2048 * D * 2;
constexpr size_t OFF_GATE = OFF_LIST + (size_t)NE * T * 4;

extern "C" __global__ __launch_bounds__(256) void mega(Params P) {
    extern __shared__ __attribute__((aligned(16))) char smem[];
    __shared__ uint4 xb_words;
    if (threadIdx.x == 0) xb_words = make_uint4(0u, 0u, 0u, 0u);
    __syncthreads();
    unsigned* bar = (unsigned*)P.ws;
    XcdBarrier xb = xcd_barrier_post(bar, (volatile LAS unsigned*)&xb_words);
    int* cnt = (int*)(P.ws + 16384);
    bf16_t* H = (bf16_t*)(P.ws + OFF_H);
    bf16_t* Z = (bf16_t*)(P.ws + OFF_Z);
    bf16_t* MIX = (bf16_t*)(P.ws + OFF_MIX);
    bf16_t* ACT = (bf16_t*)(P.ws + OFF_ACT);
    float* SC = (float*)(P.ws + OFF_ACT);
    bf16_t* Q = Z; bf16_t* PB = MIX; bf16_t* O = H;
    bf16_t* MN = (bf16_t*)(P.ws + OFF_MN);
    bf16_t* KB = (bf16_t*)(P.ws + OFF_KB);
    bf16_t* VB = (bf16_t*)(P.ws + OFF_VB);
    int* list = (int*)(P.ws + OFF_LIST);
    float* gatev = (float*)(P.ws + OFF_GATE);
    float* X = P.out;

    for (int l = 0; l < 2; ++l) {
        const float* Xsrc = (l == 0) ? P.in[0] : X;
        rmsnorm_phase<false, false>(Xsrc, P.in[2] + l * D, H, T, nullptr, nullptr, nullptr, nullptr);
        xcd_barrier(xb);
        { GemmP g{}; g.A = H; g.lda = D; g.B = P.in[3] + (long)l * D * DIN; g.ldb = DIN; g.M = T; g.N = DIN; g.K = D; g.nbatch = 1; g.C = Z; g.ldc = DIN;
          gemm<0, 0, false>(g, smem); }
        xcd_barrier(xb);
        mixer_phase(Z, MIX, smem, P.in[4] + l * 31 * 384, P.in[5] + l * 384, P.in[6] + l * 384, P.in[7] + l * 384,
                    P.in[8] + l * 384, P.in[9] + l * 384, P.in[10] + (long)l * 4 * 128 * 128, P.in[11] + l * 4 * 128,
                    P.in[12] + l * 4 * 64 * 64, P.in[13] + l * 256, P.in[14] + l * 256);
        xcd_barrier(xb);
        { GemmP g{}; g.A = MIX; g.lda = D; g.B = P.in[15] + (long)l * D * D; g.ldb = D; g.M = T; g.N = D; g.K = D; g.nbatch = 1; g.C = X; g.ldc = D; g.R = Xsrc;
          gemm<0, 2, false>(g, smem); }
        xcd_barrier(xb);
        rmsnorm_phase<false, false>(X, P.in[16] + l * D, H, T, nullptr, nullptr, nullptr, nullptr);
        rmsnorm_phase<false, false>(P.in[1], P.in[17] + l * D, MN, 2048, nullptr, nullptr, nullptr, nullptr);
        xcd_barrier(xb);
        { GemmP g{}; g.A = H; g.lda = D; g.B = P.in[18] + (long)l * D * D; g.ldb = D; g.M = T; g.N = D; g.K = D; g.nbatch = 1; g.C = Q; g.ldc = D;
          gemm<0, 0, false>(g, smem);
          g.A = MN; g.M = 2048; g.B = P.in[19] + (long)l * D * D; g.C = KB; gemm<0, 0, false>(g, smem);
          g.B = P.in[20] + (long)l * D * D; g.C = VB; gemm<0, 0, false>(g, smem); }
        xcd_barrier(xb);
        { GemmP g{}; g.A = Q; g.lda = D; g.B = KB; g.ldb = D; g.M = S; g.N = 256; g.K = 256; g.nbatch = 32;
          g.aB1 = (long)S * D; g.aB2 = 256; g.bB1 = 256L * D; g.bB2 = 256; g.cB1 = (long)S * D; g.cB2 = 256; g.C = SC; g.ldc = D; g.scale = 0.0625f;
          gemm<1, 1, false>(g, smem); }
        xcd_barrier(xb);
        softmax_phase(SC, PB);
        xcd_barrier(xb);
        { GemmP g{}; g.A = PB; g.lda = D; g.B = VB; g.ldb = D; g.M = S; g.N = 256; g.K = 256; g.nbatch = 32;
          g.aB1 = (long)S * D; g.aB2 = 256; g.bB1 = 256L * D; g.bB2 = 256; g.cB1 = (long)S * D; g.cB2 = 256; g.C = O; g.ldc = D;
          gemm<2, 0, false>(g, smem); }
        xcd_barrier(xb);
        { GemmP g{}; g.A = O; g.lda = D; g.B = P.in[21] + (long)l * D * D; g.ldb = D; g.M = T; g.N = D; g.K = D; g.nbatch = 1; g.C = X; g.ldc = D; g.R = X;
          gemm<0, 2, false>(g, smem); }
        xcd_barrier(xb);
        if (l == 0) rmsnorm_phase<false, false>(X, P.in[22] + l * D, H, T, nullptr, nullptr, nullptr, nullptr);
        else rmsnorm_phase<false, true>(X, P.in[22] + l * D, H, T, P.in[26], cnt, list, gatev);
        xcd_barrier(xb);
        if (l == 0) {
            { GemmP g{}; g.A = H; g.lda = D; g.B = P.in[23]; g.B2 = P.in[24]; g.ldb = DFF; g.M = T; g.N = DFF; g.K = D; g.nbatch = 1; g.C = ACT; g.ldc = DFF;
              gemm<0, 3, true>(g, smem); }
            xcd_barrier(xb);
            { GemmP g{}; g.A = ACT; g.lda = DFF; g.B = P.in[25]; g.ldb = D; g.M = T; g.N = D; g.K = DFF; g.nbatch = 1; g.C = X; g.ldc = D; g.R = X;
              gemm<0, 2, false>(g, smem); }
            xcd_barrier(xb);
        } else {
            for (int e = 0; e < NE; ++e) {
                const int Me = __hip_atomic_load(&cnt[e], __ATOMIC_RELAXED, __HIP_MEMORY_SCOPE_AGENT);
                { GemmP g{}; g.A = H; g.lda = D; g.gatherA = list + e * T; g.B = P.in[27] + (long)e * D * DFF; g.B2 = P.in[28] + (long)e * D * DFF; g.ldb = DFF;
                  g.M = Me; g.N = DFF; g.K = D; g.nbatch = 1; g.C = ACT; g.ldc = DFF;
                  if (Me > 0) gemm<0, 3, true>(g, smem); }
                xcd_barrier(xb);
                { GemmP g{}; g.A = ACT; g.lda = DFF; g.B = P.in[29] + (long)e * DFF * D; g.ldb = D; g.M = Me; g.N = D; g.K = DFF; g.nbatch = 1; g.C = X; g.ldc = D;
                  g.scatter = list + e * T; g.gate = gatev + e * T;
                  if (Me > 0) gemm<0, 4, false>(g, smem); }
                xcd_barrier(xb);
            }
        }
    }
    rmsnorm_phase<true, false>(X, P.in[30], X, T, nullptr, nullptr, nullptr, nullptr);
}

extern "C" void kernel_launch(void* const* d_in, const int* in_sizes, int n_in,
                              void* d_out, int out_size, void* d_ws, size_t ws_size,
                              hipStream_t stream) {
    Params p{};
    for (int i = 0; i < 31; ++i) p.in[i] = (const float*)d_in[i];
    p.out = (float*)d_out; p.ws = (char*)d_ws;
    hipFuncSetAttribute((const void*)mega, hipFuncAttributeMaxDynamicSharedMemorySize, LDS_BYTES);
    int dev = 0; hipGetDevice(&dev);
    int ncu = 256; hipDeviceGetAttribute(&ncu, hipDeviceAttributeMultiprocessorCount, dev);
    int per_cu = 0;
    if (hipOccupancyMaxActiveBlocksPerMultiprocessor(&per_cu, (const void*)mega, 256, LDS_BYTES) != hipSuccess || per_cu < 1) return;
    const int grid = ncu;
    hipMemsetAsync(d_ws, 0, 32768, stream);
    hipLaunchKernelGGL(mega, dim3(grid), dim3(256), LDS_BYTES, stream, p);
}
```

```cpp
#include <hip/hip_runtime.h>
#include <stdint.h>

#define XB_TMO      128
#define XB_XCNT(j)  (256  + 64 * (j))
#define XB_XSUB(j)  (1280 + 64 * (j))
#define XB_XGEN(j)  (2304 + 64 * (j))
#define XB_TOP      3328
#define XB_TOPGEN   3392
#define XCD_BAR_WORDS 3456
#define XB_SPIN_CAP (1u << 22)
#define LAS __attribute__((address_space(3)))

__device__ __forceinline__ unsigned xb_ld(unsigned* p)              { return __hip_atomic_load(p, __ATOMIC_RELAXED, __HIP_MEMORY_SCOPE_AGENT); }
__device__ __forceinline__ unsigned xb_add(unsigned* p, unsigned v) { return __hip_atomic_fetch_add(p, v, __ATOMIC_RELAXED, __HIP_MEMORY_SCOPE_AGENT); }
__device__ __forceinline__ unsigned xb_xcc_id() { return (unsigned)__builtin_amdgcn_s_getreg((3 << 11) | 20) & 0xFu; }
#define XB_SPIN(cond, bar) do { unsigned _sp = 0; while (cond) { __builtin_amdgcn_s_sleep(1); \
    if ((++_sp & 255u) == 0u) { if (xb_ld(&(bar)[XB_TMO])) break; if (_sp > XB_SPIN_CAP) { atomicAdd(&(bar)[XB_TMO], 1u); break; } } } } while (0)

struct XcdBarrier { unsigned* bar; unsigned x; volatile LAS unsigned* st; };

__device__ __forceinline__ XcdBarrier xcd_barrier_post(unsigned* bar, volatile LAS unsigned* st) {
    XcdBarrier b; b.bar = bar; b.x = xb_xcc_id(); b.st = st;
    if (threadIdx.x == 0) (void)xb_add(&bar[XB_XCNT(b.x)], 1u);
    return b;
}
__device__ __forceinline__ void xcd_barrier_complete(unsigned* bar, unsigned x, unsigned& nloc, unsigned& nx) {
    const unsigned G = gridDim.x * gridDim.y * gridDim.z;
    unsigned sum, cnt, mine, sp = 0u;
    for (;;) {
        sum = 0u; cnt = 0u; mine = 0u;
#pragma unroll
        for (unsigned j = 0; j < 16; ++j) { const unsigned c = xb_ld(&bar[XB_XCNT(j)]); sum += c; cnt += (c > 0u) ? 1u : 0u; mine = (j == x) ? c : mine; }
        if (sum == G) break;
        __builtin_amdgcn_s_sleep(1);
        if ((++sp & 255u) == 0u) { if (xb_ld(&bar[XB_TMO])) break; if (sp > XB_SPIN_CAP) { atomicAdd(&bar[XB_TMO], 1u); break; } }
    }
    nloc = mine > 0u ? mine : 1u; nx = cnt > 0u ? cnt : 1u;
}
__device__ __forceinline__ void xcd_barrier(const XcdBarrier& b) {
    asm volatile("s_waitcnt vmcnt(0)" ::: "memory");
    __syncthreads();
    if (threadIdx.x == 0) {
        unsigned* bar = b.bar;
        __builtin_amdgcn_s_waitcnt(0);
        unsigned nloc = b.st[0], nx = b.st[1];
        if (nloc == 0u) { xcd_barrier_complete(bar, b.x, nloc, nx); b.st[0] = nloc; b.st[1] = nx; }
        const unsigned old = xb_add(&bar[XB_XSUB(b.x)], 1u);
        const unsigned gen = old / nloc;
        if (old + 1u == (gen + 1u) * nloc) {
            __builtin_amdgcn_fence(__ATOMIC_RELEASE, "agent");
            asm volatile("s_waitcnt vmcnt(0)" ::: "memory");
            const unsigned og = xb_add(&bar[XB_TOP], 1u);
            const unsigned tg = og / nx;
            if (og + 1u == (tg + 1u) * nx) xb_add(&bar[XB_TOPGEN], 1u);
            else XB_SPIN(xb_ld(&bar[XB_TOPGEN]) == tg, bar);
            __builtin_amdgcn_fence(__ATOMIC_ACQUIRE, "agent");
            xb_add(&bar[XB_XGEN(b.x)], 1u);
            asm volatile("s_waitcnt vmcnt(0)" ::: "memory");
        } else {
            XB_SPIN(xb_ld(&bar[XB_XGEN(b.x)]) == gen, bar);
            __builtin_amdgcn_fence(__ATOMIC_ACQUIRE, "agent");
            asm volatile("s_waitcnt vmcnt(0)" ::: "memory");
        }
    }
    __syncthreads();
}

typedef unsigned short bf16_t;
typedef short s16x4 __attribute__((ext_vector_type(4)));
typedef float f32x16 __attribute__((ext_vector_type(16)));

__device__ __forceinline__ bf16_t f2bf(float f) { unsigned u = __float_as_uint(f); u += 0x7fffu + ((u >> 16) & 1u); return (bf16_t)(u >> 16); }
__device__ __forceinline__ float bf2f(bf16_t h) { return __uint_as_float(((unsigned)h) << 16); }
__device__ __forceinline__ unsigned pack2(float a, float b) { return (unsigned)f2bf(a) | ((unsigned)f2bf(b) << 16); }
__device__ __forceinline__ float wsum(float v) {
#pragma unroll
    for (int o = 32; o > 0; o >>= 1) v += __shfl_xor(v, o, 64);
    return v;
}
__device__ __forceinline__ float wmax(float v) {
#pragma unroll
    for (int o = 32; o > 0; o >>= 1) v = fmaxf(v, __shfl_xor(v, o, 64));
    return v;
}
__device__ __forceinline__ float gelu_t(float x) { return 0.5f * x * (1.f + tanhf(0.7978845608028654f * (x + 0.044715f * x * x * x))); }
__device__ __forceinline__ float sigm(float x) { return 1.f / (1.f + __expf(-x)); }

constexpr int T = 32768, D = 1024, S = 4096, DIN = 1792, DFF = 2816, NE = 8;
constexpr int LDS_BYTES = 65536 + 49152 + 1024;

struct GemmP {
    const bf16_t* A; long lda; const int* gatherA;
    const void* B; const void* B2; long ldb;
    int M, N, K, nbatch;
    long aB1, aB2, bB1, bB2, cB1, cB2;
    void* C; long ldc; const float* R; float scale; const int* scatter; const float* gate;
};
template <int BMODE, int EPI, bool DUAL>
__device__ __forceinline__ void gemm(const GemmP& p, char* smem) {
    constexpr int LS = 72;
    bf16_t* sA = (bf16_t*)smem;
    bf16_t* sB = sA + 128 * LS;
    int tid = threadIdx.x; asm volatile("" : "+v"(tid));
    const int lane = tid & 63, wave = tid >> 6, wr = wave >> 1, wc = wave & 1;
    const int mt = (p.M + 127) >> 7, nt = p.N >> 7, per = mt * nt, total = per * p.nbatch, nk = p.K >> 6;
    for (int tile = blockIdx.x; tile < total; tile += gridDim.x) {
        const int batch = tile / per, rem = tile - batch * per, tn = rem / mt, tm = rem - tn * mt;
        const long aoff = (long)(batch >> 2) * p.aB1 + (long)(batch & 3) * p.aB2;
        const long boff = (long)(batch >> 2) * p.bB1 + (long)(batch & 3) * p.bB2;
        const long coff = (long)(batch >> 2) * p.cB1 + (long)(batch & 3) * p.cB2;
        const bf16_t *arow0, *arow1, *arow2, *arow3;
        {
            int r0 = tm * 128 + (tid >> 3), r1 = r0 + 32, r2 = r0 + 64, r3 = r0 + 96;
            if (r0 >= p.M) r0 = p.M - 1; if (r1 >= p.M) r1 = p.M - 1; if (r2 >= p.M) r2 = p.M - 1; if (r3 >= p.M) r3 = p.M - 1;
            const long s0 = p.gatherA ? (long)p.gatherA[r0] : (long)r0, s1 = p.gatherA ? (long)p.gatherA[r1] : (long)r1;
            const long s2 = p.gatherA ? (long)p.gatherA[r2] : (long)r2, s3 = p.gatherA ? (long)p.gatherA[r3] : (long)r3;
            const bf16_t* ab = p.A + aoff + (tid & 7) * 8;
            arow0 = ab + s0 * p.lda; arow1 = ab + s1 * p.lda; arow2 = ab + s2 * p.lda; arow3 = ab + s3 * p.lda;
        }
        uint4 ar0, ar1, ar2, ar3;
        float bfv[DUAL ? 64 : 32];
        unsigned bu[32];
        const int bn = tid & 127, bkh = tid >> 7;
        auto loadg = [&](int kt) {
            const int k0 = kt * 64;
            ar0 = *(const uint4*)(arow0 + k0); ar1 = *(const uint4*)(arow1 + k0); ar2 = *(const uint4*)(arow2 + k0); ar3 = *(const uint4*)(arow3 + k0);
            if constexpr (BMODE == 0) {
                const float* Bp = (const float*)p.B + boff + tn * 128 + bn;
#pragma unroll
                for (int j = 0; j < 8; ++j)
#pragma unroll
                    for (int q = 0; q < 4; ++q) bfv[j * 4 + q] = Bp[(long)(k0 + (bkh + 2 * j) * 4 + q) * p.ldb];
                if constexpr (DUAL) {
                    const float* Bq = (const float*)p.B2 + boff + tn * 128 + bn;
#pragma unroll
                    for (int j = 0; j < 8; ++j)
#pragma unroll
                        for (int q = 0; q < 4; ++q) bfv[32 + j * 4 + q] = Bq[(long)(k0 + (bkh + 2 * j) * 4 + q) * p.ldb];
                }
            } else if constexpr (BMODE == 1) {
                const bf16_t* Bp = (const bf16_t*)p.B + boff + (long)(tn * 128 + (tid >> 1)) * p.ldb + k0 + (tid & 1) * 32;
#pragma unroll
                for (int j = 0; j < 4; ++j) { const uint4 v = *(const uint4*)(Bp + j * 8); bu[j * 4] = v.x; bu[j * 4 + 1] = v.y; bu[j * 4 + 2] = v.z; bu[j * 4 + 3] = v.w; }
            } else {
                const bf16_t* Bp = (const bf16_t*)p.B + boff + tn * 128 + bn;
#pragma unroll
                for (int j = 0; j < 8; ++j)
#pragma unroll
                    for (int q = 0; q < 4; ++q) bu[j * 4 + q] = Bp[(long)(k0 + (bkh + 2 * j) * 4 + q) * p.ldb];
            }
        };
        auto stores = [&]() {
            bf16_t* da = sA + (tid >> 3) * LS + (tid & 7) * 8;
            *(uint4*)da = ar0; *(uint4*)(da + 32 * LS) = ar1; *(uint4*)(da + 64 * LS) = ar2; *(uint4*)(da + 96 * LS) = ar3;
            if constexpr (BMODE == 0) {
#pragma unroll
                for (int j = 0; j < 8; ++j) {
                    uint2 v; v.x = pack2(bfv[j * 4], bfv[j * 4 + 1]); v.y = pack2(bfv[j * 4 + 2], bfv[j * 4 + 3]);
                    *(uint2*)(sB + bn * LS + (bkh + 2 * j) * 4) = v;
                    if constexpr (DUAL) {
                        uint2 w; w.x = pack2(bfv[32 + j * 4], bfv[32 + j * 4 + 1]); w.y = pack2(bfv[32 + j * 4 + 2], bfv[32 + j * 4 + 3]);
                        *(uint2*)(sB + (128 + bn) * LS + (bkh + 2 * j) * 4) = w;
                    }
                }
            } else if constexpr (BMODE == 1) {
                bf16_t* d = sB + (tid >> 1) * LS + (tid & 1) * 32;
#pragma unroll
                for (int j = 0; j < 4; ++j) { uint4 v; v.x = bu[j * 4]; v.y = bu[j * 4 + 1]; v.z = bu[j * 4 + 2]; v.w = bu[j * 4 + 3]; *(uint4*)(d + j * 8) = v; }
            } else {
#pragma unroll
                for (int j = 0; j < 8; ++j) {
                    uint2 v; v.x = bu[j * 4] | (bu[j * 4 + 1] << 16); v.y = bu[j * 4 + 2] | (bu[j * 4 + 3] << 16);
                    *(uint2*)(sB + bn * LS + (bkh + 2 * j) * 4) = v;
                }
            }
        };
        f32x16 acc[2][2], acc2[2][2];
#pragma unroll
        for (int a = 0; a < 2; ++a)
#pragma unroll
            for (int b = 0; b < 2; ++b)
#pragma unroll
                for (int i = 0; i < 16; ++i) { acc[a][b][i] = 0.f; acc2[a][b][i] = 0.f; }
        loadg(0);
#pragma unroll 1
        for (int kt = 0; kt < nk; ++kt) {
            __syncthreads();
            stores();
            __syncthreads();
            if (kt + 1 < nk) loadg(kt + 1);
#pragma unroll
            for (int ks = 0; ks < 8; ++ks) {
                const int kk = ks * 8 + (lane >> 5) * 4;
                s16x4 af[2], bfr[2], bf2[2];
#pragma unroll
                for (int mi = 0; mi < 2; ++mi) af[mi] = *(const s16x4*)(sA + (wr * 64 + mi * 32 + (lane & 31)) * LS + kk);
#pragma unroll
                for (int ni = 0; ni < 2; ++ni) {
                    bfr[ni] = *(const s16x4*)(sB + (wc * 64 + ni * 32 + (lane & 31)) * LS + kk);
                    if constexpr (DUAL) bf2[ni] = *(const s16x4*)(sB + (128 + wc * 64 + ni * 32 + (lane & 31)) * LS + kk);
                }
#pragma unroll
                for (int mi = 0; mi < 2; ++mi)
#pragma unroll
                    for (int ni = 0; ni < 2; ++ni) {
                        acc[mi][ni] = __builtin_amdgcn_mfma_f32_32x32x8bf16_1k(af[mi], bfr[ni], acc[mi][ni], 0, 0, 0);
                        if constexpr (DUAL) acc2[mi][ni] = __builtin_amdgcn_mfma_f32_32x32x8bf16_1k(af[mi], bf2[ni], acc2[mi][ni], 0, 0, 0);
                    }
            }
        }
#pragma unroll
        for (int mi = 0; mi < 2; ++mi)
#pragma unroll
            for (int ni = 0; ni < 2; ++ni)
#pragma unroll
                for (int i = 0; i < 16; ++i) {
                    const int r = tm * 128 + wr * 64 + mi * 32 + (i >> 2) * 8 + (lane >> 5) * 4 + (i & 3);
                    const int c = tn * 128 + wc * 64 + ni * 32 + (lane & 31);
                    if (r < p.M) {
                        const float v = acc[mi][ni][i];
                        const long idx = coff + (long)r * p.ldc + c;
                        if constexpr (EPI == 0) ((bf16_t*)p.C)[idx] = f2bf(v);
                        else if constexpr (EPI == 1) ((float*)p.C)[idx] = v * p.scale;
                        else if constexpr (EPI == 2) ((float*)p.C)[idx] = p.R[idx] + v;
                        else if constexpr (EPI == 3) { const float u = acc2[mi][ni][i]; ((bf16_t*)p.C)[idx] = f2bf(v * sigm(v) * u); }
                        else { const long tk = p.scatter[r]; float* x = (float*)p.C + tk * p.ldc + c; *x = *x + p.gate[r] * v; }
                    }
                }
    }
}

template <bool OUTF, bool ROUTER>
__device__ __forceinline__ void rmsnorm_phase(const float* X, const float* g, void* out, int rows,
                                              const float* rw, int* cnt, int* list, float* gatev) {
    int tid = threadIdx.x; asm volatile("" : "+v"(tid));
    const int lane = tid & 63, wave = tid >> 6;
    for (int row = blockIdx.x * 4 + wave; row < rows; row += gridDim.x * 4) {
        const float* xr = X + (long)row * D;
        float4 v[4]; float ss = 0.f;
#pragma unroll
        for (int j = 0; j < 4; ++j) { v[j] = *(const float4*)(xr + (j * 64 + lane) * 4); ss += v[j].x * v[j].x + v[j].y * v[j].y + v[j].z * v[j].z + v[j].w * v[j].w; }
        ss = wsum(ss);
        const float rs = rsqrtf(ss * (1.f / D) + 1e-6f);
        float lg[NE];
        if constexpr (ROUTER) {
#pragma unroll
            for (int e = 0; e < NE; ++e) lg[e] = 0.f;
        }
#pragma unroll
        for (int j = 0; j < 4; ++j) {
            const int c = (j * 64 + lane) * 4;
            const float4 gg = *(const float4*)(g + c);
            float4 y; y.x = v[j].x * rs * gg.x; y.y = v[j].y * rs * gg.y; y.z = v[j].z * rs * gg.z; y.w = v[j].w * rs * gg.w;
            if constexpr (OUTF) *(float4*)((float*)out + (long)row * D + c) = y;
            else { uint2 pk; pk.x = pack2(y.x, y.y); pk.y = pack2(y.z, y.w); *(uint2*)((bf16_t*)out + (long)row * D + c) = pk; }
            if constexpr (ROUTER) {
                const float4 r0 = *(const float4*)(rw + (long)c * NE), r1 = *(const float4*)(rw + (long)c * NE + 4);
                const float4 r2 = *(const float4*)(rw + (long)(c + 1) * NE), r3 = *(const float4*)(rw + (long)(c + 1) * NE + 4);
                const float4 r4 = *(const float4*)(rw + (long)(c + 2) * NE), r5 = *(const float4*)(rw + (long)(c + 2) * NE + 4);
                const float4 r6 = *(const float4*)(rw + (long)(c + 3) * NE), r7 = *(const float4*)(rw + (long)(c + 3) * NE + 4);
                lg[0] += y.x * r0.x + y.y * r2.x + y.z * r4.x + y.w * r6.x; lg[1] += y.x * r0.y + y.y * r2.y + y.z * r4.y + y.w * r6.y;
                lg[2] += y.x * r0.z + y.y * r2.z + y.z * r4.z + y.w * r6.z; lg[3] += y.x * r0.w + y.y * r2.w + y.z * r4.w + y.w * r6.w;
                lg[4] += y.x * r1.x + y.y * r3.x + y.z * r5.x + y.w * r7.x; lg[5] += y.x * r1.y + y.y * r3.y + y.z * r5.y + y.w * r7.y;
                lg[6] += y.x * r1.z + y.y * r3.z + y.z * r5.z + y.w * r7.z; lg[7] += y.x * r1.w + y.y * r3.w + y.z * r5.w + y.w * r7.w;
            }
        }
        if constexpr (ROUTER) {
#pragma unroll
            for (int e = 0; e < NE; ++e) lg[e] = wsum(lg[e]);
            if (lane == 0) {
                int i0 = 0; float v0 = lg[0];
#pragma unroll
                for (int e = 1; e < NE; ++e) if (lg[e] > v0) { v0 = lg[e]; i0 = e; }
                int i1 = -1; float v1 = -3.0e38f;
#pragma unroll
                for (int e = 0; e < NE; ++e) if (e != i0 && lg[e] > v1) { v1 = lg[e]; i1 = e; }
                const float e1 = __expf(v1 - v0), g0 = 1.f / (1.f + e1), g1 = e1 / (1.f + e1);
                const int s0 = atomicAdd(&cnt[i0], 1); list[i0 * T + s0] = row; gatev[i0 * T + s0] = g0;
                const int s1 = atomicAdd(&cnt[i1], 1); list[i1 * T + s1] = row; gatev[i1 * T + s1] = g1;
            }
        }
    }
}

__device__ __forceinline__ void softmax_phase(const float* Sc, bf16_t* P) {
    int tid = threadIdx.x; asm volatile("" : "+v"(tid));
    const int lane = tid & 63, wave = tid >> 6;
    for (int it = blockIdx.x * 4 + wave; it < T * 4; it += gridDim.x * 4) {
        const float4 v = *(const float4*)(Sc + (long)it * 256 + lane * 4);
        const float m = wmax(fmaxf(fmaxf(v.x, v.y), fmaxf(v.z, v.w)));
        const float e0 = __expf(v.x - m), e1 = __expf(v.y - m), e2 = __expf(v.z - m), e3 = __expf(v.w - m);
        const float inv = 1.f / wsum(e0 + e1 + e2 + e3);
        uint2 pk; pk.x = pack2(e0 * inv, e1 * inv); pk.y = pack2(e2 * inv, e3 * inv);
        *(uint2*)(P + (long)it * 256 + lane * 4) = pk;
    }
}

__device__ __forceinline__ void mixer_phase(const bf16_t* Z, bf16_t* MIX, char* smem,
        const float* conv_w, const float* conv_b, const float* cln_g, const float* cln_b,
        const float* sln_g, const float* sln_b, const float* sgu_w, const float* sgu_b,
        const float* pool_w, const float* pool_b, const float* pool_scale) {
    int tid = threadIdx.x; asm volatile("" : "+v"(tid));
    const int lane = tid & 63, wave = tid >> 6;
    for (int unit = blockIdx.x; unit < 256; unit += gridDim.x) {
        const int b = unit >> 5, t0 = (unit & 31) * 128;
        const long rb = (long)b * S;
        {
            float* hs = (float*)smem;
            float* ys = hs + 46 * 384;
#pragma unroll 1
            for (int sb = 0; sb < 8; ++sb) {
                const int ts = t0 + sb * 16;
#pragma unroll 3
                for (int idx = tid; idx < 46 * 384; idx += 256) {
                    const int r = idx / 384, c = idx - r * 384, t = ts - 30 + r;
                    float v = 0.f;
                    if (t >= 0) { const bf16_t* zr = Z + (rb + t) * DIN; v = bf2f(zr[c]) * sigm(bf2f(zr[384 + c])); }
                    hs[idx] = v;
                }
                __syncthreads();
                const int pg = tid >> 7, cl = tid & 127;
#pragma unroll 1
                for (int k = 0; k < 3; ++k) {
                    const int c = cl + 128 * k;
                    float w[31];
#pragma unroll
                    for (int j = 0; j < 31; ++j) w[j] = conv_w[j * 384 + c];
                    float acc[8];
                    const float cb = conv_b[c];
#pragma unroll
                    for (int q = 0; q < 8; ++q) acc[q] = cb;
#pragma unroll
                    for (int i = 0; i < 38; ++i) {
                        const float hv = hs[(pg * 8 + i) * 384 + c];
#pragma unroll
                        for (int q = 0; q < 8; ++q) { if (i - q >= 0 && i - q <= 30) acc[q] += w[i - q] * hv; }
                    }
#pragma unroll
                    for (int q = 0; q < 8; ++q) ys[(pg * 8 + q) * 384 + c] = acc[q];
                }
                __syncthreads();
#pragma unroll
                for (int rr = 0; rr < 4; ++rr) {
                    const int r = wave * 4 + rr;
                    float v[6]; float s = 0.f;
#pragma unroll
                    for (int q = 0; q < 6; ++q) { v[q] = ys[r * 384 + lane + 64 * q]; s += v[q]; }
                    const float mean = wsum(s) * (1.f / 384.f);
                    float s2 = 0.f;
#pragma unroll
                    for (int q = 0; q < 6; ++q) { const float d = v[q] - mean; s2 += d * d; }
                    const float rstd = rsqrtf(wsum(s2) * (1.f / 384.f) + 1e-6f);
#pragma unroll
                    for (int q = 0; q < 6; ++q) {
                        const int c = lane + 64 * q;
                        const float y = (v[q] - mean) * rstd * cln_g[c] + cln_b[c];
                        MIX[(rb + ts + r) * D + c] = f2bf(y * sigm(y));
                    }
                }
                __syncthreads();
            }
        }
        {
            float* wsm = (float*)smem;
            float* vs = wsm + 128 * 128;
            float* st = vs + 128 * 96;
#pragma unroll 4
            for (int rr = 0; rr < 32; ++rr) {
                const int r = wave * 32 + rr;
                const bf16_t* zr = Z + (rb + t0 + r) * DIN + 1152;
                float v[6]; float s = 0.f;
#pragma unroll
                for (int q = 0; q < 6; ++q) { v[q] = gelu_t(bf2f(zr[lane + 64 * q])); s += v[q]; }
                const float mean = wsum(s) * (1.f / 384.f);
                float s2 = 0.f;
#pragma unroll
                for (int q = 0; q < 6; ++q) { const float d = v[q] - mean; s2 += d * d; }
                const float rstd = rsqrtf(wsum(s2) * (1.f / 384.f) + 1e-6f);
                if (lane == 0) { st[r] = mean; st[128 + r] = rstd; }
            }
            __syncthreads();
#pragma unroll 1
            for (int h = 0; h < 4; ++h) {
                const float4* wsrc = (const float4*)(sgu_w + (long)h * 128 * 128);
                for (int idx = tid; idx < 128 * 32; idx += 256) ((float4*)wsm)[idx] = wsrc[idx];
#pragma unroll 4
                for (int idx = tid; idx < 128 * 96; idx += 256) {
                    const int r = idx / 96, d = idx - r * 96, ch = h * 96 + d;
                    const float v = gelu_t(bf2f(Z[(rb + t0 + r) * DIN + 1152 + ch]));
                    vs[idx] = (v - st[r]) * st[128 + r] * sln_g[ch] + sln_b[ch];
                }
                __syncthreads();
                const int ig = tid >> 5, dl = tid & 31, jmax = ig < 4 ? 64 : 128;
                float acc[16][3];
#pragma unroll
                for (int ii = 0; ii < 16; ++ii) { acc[ii][0] = 0.f; acc[ii][1] = 0.f; acc[ii][2] = 0.f; }
#pragma unroll 1
                for (int j4 = 0; j4 < jmax; j4 += 4) {
                    float vv[4][3];
#pragma unroll
                    for (int q = 0; q < 4; ++q)
#pragma unroll
                        for (int k = 0; k < 3; ++k) vv[q][k] = vs[(j4 + q) * 96 + dl + 32 * k];
#pragma unroll
                    for (int ii = 0; ii < 16; ++ii) {
                        const float4 w4 = *(const float4*)(wsm + (ig * 16 + ii) * 128 + j4);
#pragma unroll
                        for (int k = 0; k < 3; ++k) acc[ii][k] += w4.x * vv[0][k] + w4.y * vv[1][k] + w4.z * vv[2][k] + w4.w * vv[3][k];
                    }
                }
#pragma unroll
                for (int ii = 0; ii < 16; ++ii) {
                    const int i = ig * 16 + ii;
                    const float sb = sgu_b[h * 128 + i];
#pragma unroll
                    for (int k = 0; k < 3; ++k) {
                        const int ch = h * 96 + dl + 32 * k;
                        const float u = gelu_t(bf2f(Z[(rb + t0 + i) * DIN + 768 + ch]));
                        MIX[(rb + t0 + i) * D + 384 + ch] = f2bf(u * (acc[ii][k] + sb));
                    }
                }
                __syncthreads();
            }
        }
        {
            float* ps = (float*)smem;
            const int ch = tid, g = ch >> 6, w = 2 << g, o = tid & 63;
#pragma unroll 1
            for (int sb = 0; sb < 4; ++sb) {
                const int ts = t0 + sb * 32;
#pragma unroll 2
                for (int r = 0; r < 32; ++r) {
                    const int t = ts + r;
                    float s = 0.f;
#pragma unroll
                    for (int k = 0; k < 16; ++k) { const bool ok = (k < w) && (t - k >= 0); const float zv = bf2f(Z[(rb + (ok ? t - k : t)) * DIN + 1536 + ch]); s += ok ? zv : 0.f; }
                    const float cnt = (float)((t + 1) < w ? (t + 1) : w);
                    ps[r * 256 + ch] = s / cnt - bf2f(Z[(rb + t) * DIN + 1536 + ch]);
                }
                __syncthreads();
                float acc[32];
#pragma unroll
                for (int r = 0; r < 32; ++r) acc[r] = 0.f;
#pragma unroll 1
                for (int i = 0; i < 64; i += 4) {
                    const float w0 = pool_w[g * 4096 + (i + 0) * 64 + o], w1 = pool_w[g * 4096 + (i + 1) * 64 + o];
                    const float w2 = pool_w[g * 4096 + (i + 2) * 64 + o], w3 = pool_w[g * 4096 + (i + 3) * 64 + o];
#pragma unroll
                    for (int r = 0; r < 32; ++r) {
                        const float4 p4 = *(const float4*)(ps + r * 256 + g * 64 + i);
                        acc[r] += p4.x * w0 + p4.y * w1 + p4.z * w2 + p4.w * w3;
                    }
                }
                const float pb = pool_b[ch], sc = pool_scale[ch];
#pragma unroll
                for (int r = 0; r < 32; ++r) MIX[(rb + ts + r) * D + 768 + ch] = f2bf((acc[r] + pb) * sc);
                __syncthreads();
            }
        }
    }
}

struct Params { const float* in[31]; float* out; char* ws; };

constexpr size_t OFF_H = 1ull << 20;
constexpr size_t OFF_Z = OFF_H + (size_t)T * D * 2;
constexpr size_t OFF_MIX = OFF_Z + (size_t)T * DIN * 2;
constexpr size_t OFF_ACT = OFF_MIX + (size_t)T * D * 2;
constexpr size_t OFF_MN = OFF_ACT + (size_t)T * DFF * 2;
constexpr size_t OFF_KB = OFF_MN + (size_t)2048 * D * 2;
constexpr size_t OFF_VB = OFF_KB + (size_t)2048 * D * 2;
constexpr size_t OFF_LIST = OFF_VB + (size_t)2048 * D * 2;
constexpr size_t OFF_GATE = OFF_LIST + (size_t)NE * T * 4;

extern "C" __global__ __launch_bounds__(256) void mega(Params P) {
    extern __shared__ __attribute__((aligned(16))) char smem[];
    __shared__ uint4 xb_words;
    if (threadIdx.x == 0) xb_words = make_uint4(0u, 0u, 0u, 0u);
    __syncthreads();
    unsigned* bar = (unsigned*)P.ws;
    XcdBarrier xb = xcd_barrier_post(bar, (volatile LAS unsigned*)&xb_words);
    int* cnt = (int*)(P.ws + 16384);
    bf16_t* H = (bf16_t*)(P.ws + OFF_H);
    bf16_t* Z = (bf16_t*)(P.ws + OFF_Z);
    bf16_t* MIX = (bf16_t*)(P.ws + OFF_MIX);
    bf16_t* ACT = (bf16_t*)(P.ws + OFF_ACT);
    float* SC = (float*)(P.ws + OFF_ACT);
    bf16_t* Q = Z; bf16_t* PB = MIX; bf16_t* O = H;
    bf16_t* MN = (bf16_t*)(P.ws + OFF_MN);
    bf16_t* KB = (bf16_t*)(P.ws + OFF_KB);
    bf16_t* VB = (bf16_t*)(P.ws + OFF_VB);
    int* list = (int*)(P.ws + OFF_LIST);
    float* gatev = (float*)(P.ws + OFF_GATE);
    float* X = P.out;

    for (int l = 0; l < 2; ++l) {
        const float* Xsrc = (l == 0) ? P.in[0] : X;
        rmsnorm_phase<false, false>(Xsrc, P.in[2] + l * D, H, T, nullptr, nullptr, nullptr, nullptr);
        xcd_barrier(xb);
        { GemmP g{}; g.A = H; g.lda = D; g.B = P.in[3] + (long)l * D * DIN; g.ldb = DIN; g.M = T; g.N = DIN; g.K = D; g.nbatch = 1; g.C = Z; g.ldc = DIN;
          gemm<0, 0, false>(g, smem); }
        xcd_barrier(xb);
        mixer_phase(Z, MIX, smem, P.in[4] + l * 31 * 384, P.in[5] + l * 384, P.in[6] + l * 384, P.in[7] + l * 384,
                    P.in[8] + l * 384, P.in[9] + l * 384, P.in[10] + (long)l * 4 * 128 * 128, P.in[11] + l * 4 * 128,
                    P.in[12] + l * 4 * 64 * 64, P.in[13] + l * 256, P.in[14] + l * 256);
        xcd_barrier(xb);
        { GemmP g{}; g.A = MIX; g.lda = D; g.B = P.in[15] + (long)l * D * D; g.ldb = D; g.M = T; g.N = D; g.K = D; g.nbatch = 1; g.C = X; g.ldc = D; g.R = Xsrc;
          gemm<0, 2, false>(g, smem); }
        xcd_barrier(xb);
        rmsnorm_phase<false, false>(X, P.in[16] + l * D, H, T, nullptr, nullptr, nullptr, nullptr);
        rmsnorm_phase<false, false>(P.in[1], P.in[17] + l * D, MN, 2048, nullptr, nullptr, nullptr, nullptr);
        xcd_barrier(xb);
        { GemmP g{}; g.A = H; g.lda = D; g.B = P.in[18] + (long)l * D * D; g.ldb = D; g.M = T; g.N = D; g.K = D; g.nbatch = 1; g.C = Q; g.ldc = D;
          gemm<0, 0, false>(g, smem);
          g.A = MN; g.M = 2048; g.B = P.in[19] + (long)l * D * D; g.C = KB; gemm<0, 0, false>(g, smem);
          g.B = P.in[20] + (long)l * D * D; g.C = VB; gemm<0, 0, false>(g, smem); }
        xcd_barrier(xb);
        { GemmP g{}; g.A = Q; g.lda = D; g.B = KB; g.ldb = D; g.M = S; g.N = 256; g.K = 256; g.nbatch = 32;
          g.aB1 = (long)S * D; g.aB2 = 256; g.bB1 = 256L * D; g.bB2 = 256; g.cB1 = (long)S * D; g.cB2 = 256; g.C = SC; g.ldc = D; g.scale = 0.0625f;
          gemm<1, 1, false>(g, smem); }
        xcd_barrier(xb);
        softmax_phase(SC, PB);
        xcd_barrier(xb);
        { GemmP g{}; g.A = PB; g.lda = D; g.B = VB; g.ldb = D; g.M = S; g.N = 256; g.K = 256; g.nbatch = 32;
          g.aB1 = (long)S * D; g.aB2 = 256; g.bB1 = 256L * D; g.bB2 = 256; g.cB1 = (long)S * D; g.cB2 = 256; g.C = O; g.ldc = D;
          gemm<2, 0, false>(g, smem); }
        xcd_barrier(xb);
        { GemmP g{}; g.A = O; g.lda = D; g.B = P.in[21] + (long)l * D * D; g.ldb = D; g.M = T; g.N = D; g.K = D; g.nbatch = 1; g.C = X; g.ldc = D; g.R = X;
          gemm<0, 2, false>(g, smem); }
        xcd_barrier(xb);
        if (l == 0) rmsnorm_phase<false, false>(X, P.in[22] + l * D, H, T, nullptr, nullptr, nullptr, nullptr);
        else rmsnorm_phase<false, true>(X, P.in[22] + l * D, H, T, P.in[26], cnt, list, gatev);
        xcd_barrier(xb);
        if (l == 0) {
            { GemmP g{}; g.A = H; g.lda = D; g.B = P.in[23]; g.B2 = P.in[24]; g.ldb = DFF; g.M = T; g.N = DFF; g.K = D; g.nbatch = 1; g.C = ACT; g.ldc = DFF;
              gemm<0, 3, true>(g, smem); }
            xcd_barrier(xb);
            { GemmP g{}; g.A = ACT; g.lda = DFF; g.B = P.in[25]; g.ldb = D; g.M = T; g.N = D; g.K = DFF; g.nbatch = 1; g.C = X; g.ldc = D; g.R = X;
              gemm<0, 2, false>(g, smem); }
            xcd_barrier(xb);
        } else {
            for (int e = 0; e < NE; ++e) {
                const int Me = __hip_atomic_load(&cnt[e], __ATOMIC_RELAXED, __HIP_MEMORY_SCOPE_AGENT);
                { GemmP g{}; g.A = H; g.lda = D; g.gatherA = list + e * T; g.B = P.in[27] + (long)e * D * DFF; g.B2 = P.in[28] + (long)e * D * DFF; g.ldb = DFF;
                  g.M = Me; g.N = DFF; g.K = D; g.nbatch = 1; g.C = ACT; g.ldc = DFF;
                  if (Me > 0) gemm<0, 3, true>(g, smem); }
                xcd_barrier(xb);
                { GemmP g{}; g.A = ACT; g.lda = DFF; g.B = P.in[29] + (long)e * DFF * D; g.ldb = D; g.M = Me; g.N = D; g.K = DFF; g.nbatch = 1; g.C = X; g.ldc = D;
                  g.scatter = list + e * T; g.gate = gatev + e * T;
                  if (Me > 0) gemm<0, 4, false>(g, smem); }
                xcd_barrier(xb);
            }
        }
    }
    rmsnorm_phase<true, false>(X, P.in[30], X, T, nullptr, nullptr, nullptr, nullptr);
}

extern "C" void kernel_launch(void* const* d_in, const int* in_sizes, int n_in,
                              void* d_out, int out_size, void* d_ws, size_t ws_size,
                              hipStream_t stream) {
    Params p{};
    for (int i = 0; i < 31; ++i) p.in[i] = (const float*)d_in[i];
    p.out = (float*)d_out; p.ws = (char*)d_ws;
    hipFuncSetAttribute((const void*)mega, hipFuncAttributeMaxDynamicSharedMemorySize, LDS_BYTES);
    int dev = 0; hipGetDevice(&dev);
    int ncu = 256; hipDeviceGetAttribute(&ncu, hipDeviceAttributeMultiprocessorCount, dev);
    int per_cu = 0;
    if (hipOccupancyMaxActiveBlocksPerMultiprocessor(&per_cu, (const void*)mega, 256, LDS_BYTES) != hipSuccess || per_cu < 1) return;
    const int grid = ncu;
    hipMemsetAsync(d_ws, 0, 32768, stream);
    hipLaunchKernelGGL(mega, dim3(grid), dim3(256), LDS_BYTES, stream, p);
}
```

```cpp
#include <hip/hip_runtime.h>
#include <stdint.h>

#define XB_TMO      128
#define XB_XCNT(j)  (256  + 64 * (j))
#define XB_XSUB(j)  (1280 + 64 * (j))
#define XB_XGEN(j)  (2304 + 64 * (j))
#define XB_TOP      3328
#define XB_TOPGEN   3392
#define XCD_BAR_WORDS 3456
#define XB_SPIN_CAP (1u << 22)
#define LAS __attribute__((address_space(3)))

__device__ __forceinline__ unsigned xb_ld(unsigned* p)              { return __hip_atomic_load(p, __ATOMIC_RELAXED, __HIP_MEMORY_SCOPE_AGENT); }
__device__ __forceinline__ unsigned xb_add(unsigned* p, unsigned v) { return __hip_atomic_fetch_add(p, v, __ATOMIC_RELAXED, __HIP_MEMORY_SCOPE_AGENT); }
__device__ __forceinline__ unsigned xb_xcc_id() { return (unsigned)__builtin_amdgcn_s_getreg((3 << 11) | 20) & 0xFu; }
#define XB_SPIN(cond, bar) do { unsigned _sp = 0; while (cond) { __builtin_amdgcn_s_sleep(1); \
    if ((++_sp & 255u) == 0u) { if (xb_ld(&(bar)[XB_TMO])) break; if (_sp > XB_SPIN_CAP) { atomicAdd(&(bar)[XB_TMO], 1u); break; } } } } while (0)

struct XcdBarrier { unsigned* bar; unsigned x; volatile LAS unsigned* st; };

__device__ __forceinline__ XcdBarrier xcd_barrier_post(unsigned* bar, volatile LAS unsigned* st) {
    XcdBarrier b; b.bar = bar; b.x = xb_xcc_id(); b.st = st;
    if (threadIdx.x == 0) (void)xb_add(&bar[XB_XCNT(b.x)], 1u);
    return b;
}
__device__ __forceinline__ void xcd_barrier_complete(unsigned* bar, unsigned x, unsigned& nloc, unsigned& nx) {
    const unsigned G = gridDim.x * gridDim.y * gridDim.z;
    unsigned sum, cnt, mine, sp = 0u;
    for (;;) {
        sum = 0u; cnt = 0u; mine = 0u;
#pragma unroll
        for (unsigned j = 0; j < 16; ++j) { const unsigned c = xb_ld(&bar[XB_XCNT(j)]); sum += c; cnt += (c > 0u) ? 1u : 0u; mine = (j == x) ? c : mine; }
        if (sum == G) break;
        __builtin_amdgcn_s_sleep(1);
        if ((++sp & 255u) == 0u) { if (xb_ld(&bar[XB_TMO])) break; if (sp > XB_SPIN_CAP) { atomicAdd(&bar[XB_TMO], 1u); break; } }
    }
    nloc = mine > 0u ? mine : 1u; nx = cnt > 0u ? cnt : 1u;
}
__device__ __forceinline__ void xcd_barrier(const XcdBarrier& b) {
    asm volatile("s_waitcnt vmcnt(0)" ::: "memory");
    __syncthreads();
    if (threadIdx.x == 0) {
        unsigned* bar = b.bar;
        __builtin_amdgcn_s_waitcnt(0);
        unsigned nloc = b.st[0], nx = b.st[1];
        if (nloc == 0u) { xcd_barrier_complete(bar, b.x, nloc, nx); b.st[0] = nloc; b.st[1] = nx; }
        const unsigned old = xb_add(&bar[XB_XSUB(b.x)], 1u);
        const unsigned gen = old / nloc;
        if (old + 1u == (gen + 1u) * nloc) {
            __builtin_amdgcn_fence(__ATOMIC_RELEASE, "agent");
            asm volatile("s_waitcnt vmcnt(0)" ::: "memory");
            const unsigned og = xb_add(&bar[XB_TOP], 1u);
            const unsigned tg = og / nx;
            if (og + 1u == (tg + 1u) * nx) xb_add(&bar[XB_TOPGEN], 1u);
            else XB_SPIN(xb_ld(&bar[XB_TOPGEN]) == tg, bar);
            __builtin_amdgcn_fence(__ATOMIC_ACQUIRE, "agent");
            xb_add(&bar[XB_XGEN(b.x)], 1u);
            asm volatile("s_waitcnt vmcnt(0)" ::: "memory");
        } else {
            XB_SPIN(xb_ld(&bar[XB_XGEN(b.x)]) == gen, bar);
            __builtin_amdgcn_fence(__ATOMIC_ACQUIRE, "agent");
            asm volatile("s_waitcnt vmcnt(0)" ::: "memory");
        }
    }
    __syncthreads();
}

typedef unsigned short bf16_t;
typedef short s16x4 __attribute__((ext_vector_type(4)));
typedef float f32x16 __attribute__((ext_vector_type(16)));

__device__ __forceinline__ bf16_t f2bf(float f) { unsigned u = __float_as_uint(f); u += 0x7fffu + ((u >> 16) & 1u); return (bf16_t)(u >> 16); }
__device__ __forceinline__ float bf2f(bf16_t h) { return __uint_as_float(((unsigned)h) << 16); }
__device__ __forceinline__ unsigned pack2(float a, float b) { return (unsigned)f2bf(a) | ((unsigned)f2bf(b) << 16); }
__device__ __forceinline__ float wsum(float v) {
#pragma unroll
    for (int o = 32; o > 0; o >>= 1) v += __shfl_xor(v, o, 64);
    return v;
}
__device__ __forceinline__ float wmax(float v) {
#pragma unroll
    for (int o = 32; o > 0; o >>= 1) v = fmaxf(v, __shfl_xor(v, o, 64));
    return v;
}
__device__ __forceinline__ float gelu_t(float x) { return 0.5f * x * (1.f + tanhf(0.7978845608028654f * (x + 0.044715f * x * x * x))); }
__device__ __forceinline__ float sigm(float x) { return 1.f / (1.f + __expf(-x)); }

constexpr int T = 32768, D = 1024, S = 4096, DIN = 1792, DFF = 2816, NE = 8;
constexpr int LDS_BYTES = 65536 + 49152 + 1024;

struct GemmP {
    const bf16_t* A; long lda; const int* gatherA;
    const void* B; const void* B2; long ldb;
    int M, N, K, nbatch;
    long aB1, aB2, bB1, bB2, cB1, cB2;
    void* C; long ldc; const float* R; float scale; const int* scatter; const float* gate;
};
template <int BMODE, int EPI, bool DUAL>
__device__ __forceinline__ void gemm(const GemmP& p, char* smem) {
    constexpr int LS = 72;
    bf16_t* sA = (bf16_t*)smem;
    bf16_t* sB = sA + 128 * LS;
    int tid = threadIdx.x; asm volatile("" : "+v"(tid));
    const int lane = tid & 63, wave = tid >> 6, wr = wave >> 1, wc = wave & 1;
    const int mt = (p.M + 127) >> 7, nt = p.N >> 7, per = mt * nt, total = per * p.nbatch, nk = p.K >> 6;
    const int G = gridDim.x, bp = (G & 7) ? (int)blockIdx.x : (int)((blockIdx.x & 7) * (G >> 3) + (blockIdx.x >> 3));
    for (int tbase = 0; tbase < total; tbase += G) {
        const int tile = tbase + bp;
        if (tile >= total) continue;
        const int batch = tile / per, rem = tile - batch * per;
        const int grp = rem / (4 * mt), gsz = (nt - 4 * grp) < 4 ? (nt - 4 * grp) : 4, gi = rem - grp * 4 * mt, tm = gi / gsz, tn = 4 * grp + (gi - tm * gsz);
        const long aoff = (long)(batch >> 2) * p.aB1 + (long)(batch & 3) * p.aB2;
        const long boff = (long)(batch >> 2) * p.bB1 + (long)(batch & 3) * p.bB2;
        const long coff = (long)(batch >> 2) * p.cB1 + (long)(batch & 3) * p.cB2;
        const bf16_t *arow0, *arow1, *arow2, *arow3;
        {
            int r0 = tm * 128 + (tid >> 3), r1 = r0 + 32, r2 = r0 + 64, r3 = r0 + 96;
            if (r0 >= p.M) r0 = p.M - 1; if (r1 >= p.M) r1 = p.M - 1; if (r2 >= p.M) r2 = p.M - 1; if (r3 >= p.M) r3 = p.M - 1;
            const long s0 = p.gatherA ? (long)p.gatherA[r0] : (long)r0, s1 = p.gatherA ? (long)p.gatherA[r1] : (long)r1;
            const long s2 = p.gatherA ? (long)p.gatherA[r2] : (long)r2, s3 = p.gatherA ? (long)p.gatherA[r3] : (long)r3;
            const bf16_t* ab = p.A + aoff + (tid & 7) * 8;
            arow0 = ab + s0 * p.lda; arow1 = ab + s1 * p.lda; arow2 = ab + s2 * p.lda; arow3 = ab + s3 * p.lda;
        }
        uint4 ar0, ar1, ar2, ar3;
        float bfv[DUAL ? 64 : 32];
        unsigned bu[32];
        const int bn = tid & 127, bkh = tid >> 7;
        auto loadg = [&](int kt) {
            const int k0 = kt * 64;
            ar0 = *(const uint4*)(arow0 + k0); ar1 = *(const uint4*)(arow1 + k0); ar2 = *(const uint4*)(arow2 + k0); ar3 = *(const uint4*)(arow3 + k0);
            if constexpr (BMODE == 0) {
                const float* Bp = (const float*)p.B + boff + tn * 128 + bn;
#pragma unroll
                for (int j = 0; j < 8; ++j)
#pragma unroll
                    for (int q = 0; q < 4; ++q) bfv[j * 4 + q] = Bp[(long)(k0 + (bkh + 2 * j) * 4 + q) * p.ldb];
                if constexpr (DUAL) {
                    const float* Bq = (const float*)p.B2 + boff + tn * 128 + bn;
#pragma unroll
                    for (int j = 0; j < 8; ++j)
#pragma unroll
                        for (int q = 0; q < 4; ++q) bfv[32 + j * 4 + q] = Bq[(long)(k0 + (bkh + 2 * j) * 4 + q) * p.ldb];
                }
            } else if constexpr (BMODE == 1) {
                const bf16_t* Bp = (const bf16_t*)p.B + boff + (long)(tn * 128 + (tid >> 1)) * p.ldb + k0 + (tid & 1) * 32;
#pragma unroll
                for (int j = 0; j < 4; ++j) { const uint4 v = *(const uint4*)(Bp + j * 8); bu[j * 4] = v.x; bu[j * 4 + 1] = v.y; bu[j * 4 + 2] = v.z; bu[j * 4 + 3] = v.w; }
            } else {
                const bf16_t* Bp = (const bf16_t*)p.B + boff + tn * 128 + bn;
#pragma unroll
                for (int j = 0; j < 8; ++j)
#pragma unroll
                    for (int q = 0; q < 4; ++q) bu[j * 4 + q] = Bp[(long)(k0 + (bkh + 2 * j) * 4 + q) * p.ldb];
            }
        };
        auto stores = [&]() {
            bf16_t* da = sA + (tid >> 3) * LS + (tid & 7) * 8;
            *(uint4*)da = ar0; *(uint4*)(da + 32 * LS) = ar1; *(uint4*)(da + 64 * LS) = ar2; *(uint4*)(da + 96 * LS) = ar3;
            if constexpr (BMODE == 0) {
#pragma unroll
                for (int j = 0; j < 8; ++j) {
                    uint2 v; v.x = pack2(bfv[j * 4], bfv[j * 4 + 1]); v.y = pack2(bfv[j * 4 + 2], bfv[j * 4 + 3]);
                    *(uint2*)(sB + bn * LS + (bkh + 2 * j) * 4) = v;
                    if constexpr (DUAL) {
                        uint2 w; w.x = pack2(bfv[32 + j * 4], bfv[32 + j * 4 + 1]); w.y = pack2(bfv[32 + j * 4 + 2], bfv[32 + j * 4 + 3]);
                        *(uint2*)(sB + (128 + bn) * LS + (bkh + 2 * j) * 4) = w;
                    }
                }
            } else if constexpr (BMODE == 1) {
                bf16_t* d = sB + (tid >> 1) * LS + (tid & 1) * 32;
#pragma unroll
                for (int j = 0; j < 4; ++j) { uint4 v; v.x = bu[j * 4]; v.y = bu[j * 4 + 1]; v.z = bu[j * 4 + 2]; v.w = bu[j * 4 + 3]; *(uint4*)(d + j * 8) = v; }
            } else {
#pragma unroll
                for (int j = 0; j < 8; ++j) {
                    uint2 v; v.x = bu[j * 4] | (bu[j * 4 + 1] << 16); v.y = bu[j * 4 + 2] | (bu[j * 4 + 3] << 16);
                    *(uint2*)(sB + bn * LS + (bkh + 2 * j) * 4) = v;
                }
            }
        };
        f32x16 acc[2][2], acc2[2][2];
#pragma unroll
        for (int a = 0; a < 2; ++a)
#pragma unroll
            for (int b = 0; b < 2; ++b)
#pragma unroll
                for (int i = 0; i < 16; ++i) { acc[a][b][i] = 0.f; acc2[a][b][i] = 0.f; }
        loadg(0);
#pragma unroll 1
        for (int kt = 0; kt < nk; ++kt) {
            __syncthreads();
            stores();
            __syncthreads();
            if (kt + 1 < nk) loadg(kt + 1);
#pragma unroll
            for (int ks = 0; ks < 8; ++ks) {
                const int kk = ks * 8 + (lane >> 5) * 4;
                s16x4 af[2], bfr[2], bf2[2];
#pragma unroll
                for (int mi = 0; mi < 2; ++mi) af[mi] = *(const s16x4*)(sA + (wr * 64 + mi * 32 + (lane & 31)) * LS + kk);
#pragma unroll
                for (int ni = 0; ni < 2; ++ni) {
                    bfr[ni] = *(const s16x4*)(sB + (wc * 64 + ni * 32 + (lane & 31)) * LS + kk);
                    if constexpr (DUAL) bf2[ni] = *(const s16x4*)(sB + (128 + wc * 64 + ni * 32 + (lane & 31)) * LS + kk);
                }
#pragma unroll
                for (int mi = 0; mi < 2; ++mi)
#pragma unroll
                    for (int ni = 0; ni < 2; ++ni) {
                        acc[mi][ni] = __builtin_amdgcn_mfma_f32_32x32x8bf16_1k(af[mi], bfr[ni], acc[mi][ni], 0, 0, 0);
                        if constexpr (DUAL) acc2[mi][ni] = __builtin_amdgcn_mfma_f32_32x32x8bf16_1k(af[mi], bf2[ni], acc2[mi][ni], 0, 0, 0);
                    }
            }
        }
#pragma unroll
        for (int mi = 0; mi < 2; ++mi)
#pragma unroll
            for (int ni = 0; ni < 2; ++ni)
#pragma unroll
                for (int i = 0; i < 16; ++i) {
                    const int r = tm * 128 + wr * 64 + mi * 32 + (i >> 2) * 8 + (lane >> 5) * 4 + (i & 3);
                    const int c = tn * 128 + wc * 64 + ni * 32 + (lane & 31);
                    if (r < p.M) {
                        const float v = acc[mi][ni][i];
                        const long idx = coff + (long)r * p.ldc + c;
                        if constexpr (EPI == 0) ((bf16_t*)p.C)[idx] = f2bf(v);
                        else if constexpr (EPI == 1) ((float*)p.C)[idx] = v * p.scale;
                        else if constexpr (EPI == 2) ((float*)p.C)[idx] = p.R[idx] + v;
                        else if constexpr (EPI == 3) { const float u = acc2[mi][ni][i]; ((bf16_t*)p.C)[idx] = f2bf(v * sigm(v) * u); }
                        else { const long tk = p.scatter[r]; float* x = (float*)p.C + tk * p.ldc + c; *x = *x + p.gate[r] * v; }
                    }
                }
    }
}

template <bool OUTF, bool ROUTER>
__device__ __forceinline__ void rmsnorm_phase(const float* X, const float* g, void* out, int rows,
                                              const float* rw, int* cnt, int* list, float* gatev) {
    int tid = threadIdx.x; asm volatile("" : "+v"(tid));
    const int lane = tid & 63, wave = tid >> 6;
    for (int row = blockIdx.x * 4 + wave; row < rows; row += gridDim.x * 4) {
        const float* xr = X + (long)row * D;
        float4 v[4]; float ss = 0.f;
#pragma unroll
        for (int j = 0; j < 4; ++j) { v[j] = *(const float4*)(xr + (j * 64 + lane) * 4); ss += v[j].x * v[j].x + v[j].y * v[j].y + v[j].z * v[j].z + v[j].w * v[j].w; }
        ss = wsum(ss);
        const float rs = rsqrtf(ss * (1.f / D) + 1e-6f);
        float lg[NE];
        if constexpr (ROUTER) {
#pragma unroll
            for (int e = 0; e < NE; ++e) lg[e] = 0.f;
        }
#pragma unroll
        for (int j = 0; j < 4; ++j) {
            const int c = (j * 64 + lane) * 4;
            const float4 gg = *(const float4*)(g + c);
            float4 y; y.x = v[j].x * rs * gg.x; y.y = v[j].y * rs * gg.y; y.z = v[j].z * rs * gg.z; y.w = v[j].w * rs * gg.w;
            if constexpr (OUTF) *(float4*)((float*)out + (long)row * D + c) = y;
            else { uint2 pk; pk.x = pack2(y.x, y.y); pk.y = pack2(y.z, y.w); *(uint2*)((bf16_t*)out + (long)row * D + c) = pk; }
            if constexpr (ROUTER) {
                const float4 r0 = *(const float4*)(rw + (long)c * NE), r1 = *(const float4*)(rw + (long)c * NE + 4);
                const float4 r2 = *(const float4*)(rw + (long)(c + 1) * NE), r3 = *(const float4*)(rw + (long)(c + 1) * NE + 4);
                const float4 r4 = *(const float4*)(rw + (long)(c + 2) * NE), r5 = *(const float4*)(rw + (long)(c + 2) * NE + 4);
                const float4 r6 = *(const float4*)(rw + (long)(c + 3) * NE), r7 = *(const float4*)(rw + (long)(c + 3) * NE + 4);
                lg[0] += y.x * r0.x + y.y * r2.x + y.z * r4.x + y.w * r6.x; lg[1] += y.x * r0.y + y.y * r2.y + y.z * r4.y + y.w * r6.y;
                lg[2] += y.x * r0.z + y.y * r2.z + y.z * r4.z + y.w * r6.z; lg[3] += y.x * r0.w + y.y * r2.w + y.z * r4.w + y.w * r6.w;
                lg[4] += y.x * r1.x + y.y * r3.x + y.z * r5.x + y.w * r7.x; lg[5] += y.x * r1.y + y.y * r3.y + y.z * r5.y + y.w * r7.y;
                lg[6] += y.x * r1.z + y.y * r3.z + y.z * r5.z + y.w * r7.z; lg[7] += y.x * r1.w + y.y * r3.w + y.z * r5.w + y.w * r7.w;
            }
        }
        if constexpr (ROUTER) {
#pragma unroll
            for (int e = 0; e < NE; ++e) lg[e] = wsum(lg[e]);
            if (lane == 0) {
                int i0 = 0; float v0 = lg[0];
#pragma unroll
                for (int e = 1; e < NE; ++e) if (lg[e] > v0) { v0 = lg[e]; i0 = e; }
                int i1 = -1; float v1 = -3.0e38f;
#pragma unroll
                for (int e = 0; e < NE; ++e) if (e != i0 && lg[e] > v1) { v1 = lg[e]; i1 = e; }
                const float e1 = __expf(v1 - v0), g0 = 1.f / (1.f + e1), g1 = e1 / (1.f + e1);
                const int s0 = atomicAdd(&cnt[i0], 1); list[i0 * T + s0] = row; gatev[i0 * T + s0] = g0;
                const int s1 = atomicAdd(&cnt[i1], 1); list[i1 * T + s1] = row; gatev[i1 * T + s1] = g1;
            }
        }
    }
}

__device__ __forceinline__ void softmax_phase(const float* Sc, bf16_t* P) {
    int tid = threadIdx.x; asm volatile("" : "+v"(tid));
    const int lane = tid & 63, wave = tid >> 6;
    for (int it = blockIdx.x * 4 + wave; it < T * 4; it += gridDim.x * 4) {
        const float4 v = *(const float4*)(Sc + (long)it * 256 + lane * 4);
        const float m = wmax(fmaxf(fmaxf(v.x, v.y), fmaxf(v.z, v.w)));
        const float e0 = __expf(v.x - m), e1 = __expf(v.y - m), e2 = __expf(v.z - m), e3 = __expf(v.w - m);
        const float inv = 1.f / wsum(e0 + e1 + e2 + e3);
        uint2 pk; pk.x = pack2(e0 * inv, e1 * inv); pk.y = pack2(e2 * inv, e3 * inv);
        *(uint2*)(P + (long)it * 256 + lane * 4) = pk;
    }
}

__device__ __forceinline__ void mixer_phase(const bf16_t* Z, bf16_t* MIX, char* smem,
        const float* conv_w, const float* conv_b, const float* cln_g, const float* cln_b,
        const float* sln_g, const float* sln_b, const float* sgu_w, const float* sgu_b,
        const float* pool_w, const float* pool_b, const float* pool_scale) {
    int tid = threadIdx.x; asm volatile("" : "+v"(tid));
    const int lane = tid & 63, wave = tid >> 6;
    for (int unit = blockIdx.x; unit < 256; unit += gridDim.x) {
        const int b = unit >> 5, t0 = (unit & 31) * 128;
        const long rb = (long)b * S;
        {
            float* hs = (float*)smem;
            float* ys = hs + 46 * 384;
#pragma unroll 1
            for (int sb = 0; sb < 8; ++sb) {
                const int ts = t0 + sb * 16;
#pragma unroll 3
                for (int idx = tid; idx < 46 * 384; idx += 256) {
                    const int r = idx / 384, c = idx - r * 384, t = ts - 30 + r;
                    float v = 0.f;
                    if (t >= 0) { const bf16_t* zr = Z + (rb + t) * DIN; v = bf2f(zr[c]) * sigm(bf2f(zr[384 + c])); }
                    hs[idx] = v;
                }
                __syncthreads();
                const int pg = tid >> 7, cl = tid & 127;
#pragma unroll 1
                for (int k = 0; k < 3; ++k) {
                    const int c = cl + 128 * k;
                    float w[31];
#pragma unroll
                    for (int j = 0; j < 31; ++j) w[j] = conv_w[j * 384 + c];
                    float acc[8];
                    const float cb = conv_b[c];
#pragma unroll
                    for (int q = 0; q < 8; ++q) acc[q] = cb;
#pragma unroll
                    for (int i = 0; i < 38; ++i) {
                        const float hv = hs[(pg * 8 + i) * 384 + c];
#pragma unroll
                        for (int q = 0; q < 8; ++q) { if (i - q >= 0 && i - q <= 30) acc[q] += w[i - q] * hv; }
                    }
#pragma unroll
                    for (int q = 0; q < 8; ++q) ys[(pg * 8 + q) * 384 + c] = acc[q];
                }
                __syncthreads();
#pragma unroll
                for (int rr = 0; rr < 4; ++rr) {
                    const int r = wave * 4 + rr;
                    float v[6]; float s = 0.f;
#pragma unroll
                    for (int q = 0; q < 6; ++q) { v[q] = ys[r * 384 + lane + 64 * q]; s += v[q]; }
                    const float mean = wsum(s) * (1.f / 384.f);
                    float s2 = 0.f;
#pragma unroll
                    for (int q = 0; q < 6; ++q) { const float d = v[q] - mean; s2 += d * d; }
                    const float rstd = rsqrtf(wsum(s2) * (1.f / 384.f) + 1e-6f);
#pragma unroll
                    for (int q = 0; q < 6; ++q) {
                        const int c = lane + 64 * q;
                        const float y = (v[q] - mean) * rstd * cln_g[c] + cln_b[c];
                        MIX[(rb + ts + r) * D + c] = f2bf(y * sigm(y));
                    }
                }
                __syncthreads();
            }
        }
        {
            float* wsm = (float*)smem;
            float* vs = wsm + 128 * 128;
            float* st = vs + 128 * 96;
#pragma unroll 4
            for (int rr = 0; rr < 32; ++rr) {
                const int r = wave * 32 + rr;
                const bf16_t* zr = Z + (rb + t0 + r) * DIN + 1152;
                float v[6]; float s = 0.f;
#pragma unroll
                for (int q = 0; q < 6; ++q) { v[q] = gelu_t(bf2f(zr[lane + 64 * q])); s += v[q]; }
                const float mean = wsum(s) * (1.f / 384.f);
                float s2 = 0.f;
#pragma unroll
                for (int q = 0; q < 6; ++q) { const float d = v[q] - mean; s2 += d * d; }
                const float rstd = rsqrtf(wsum(s2) * (1.f / 384.f) + 1e-6f);
                if (lane == 0) { st[r] = mean; st[128 + r] = rstd; }
            }
            __syncthreads();
#pragma unroll 1
            for (int h = 0; h < 4; ++h) {
                const float4* wsrc = (const float4*)(sgu_w + (long)h * 128 * 128);
                for (int idx = tid; idx < 128 * 32; idx += 256) ((float4*)wsm)[idx] = wsrc[idx];
#pragma unroll 4
                for (int idx = tid; idx < 128 * 96; idx += 256) {
                    const int r = idx / 96, d = idx - r * 96, ch = h * 96 + d;
                    const float v = gelu_t(bf2f(Z[(rb + t0 + r) * DIN + 1152 + ch]));
                    vs[idx] = (v - st[r]) * st[128 + r] * sln_g[ch] + sln_b[ch];
                }
                __syncthreads();
                const int ig = tid >> 5, dl = tid & 31, jmax = ig < 4 ? 64 : 128;
                float acc[16][3];
#pragma unroll
                for (int ii = 0; ii < 16; ++ii) { acc[ii][0] = 0.f; acc[ii][1] = 0.f; acc[ii][2] = 0.f; }
#pragma unroll 1
                for (int j4 = 0; j4 < jmax; j4 += 4) {
                    float vv[4][3];
#pragma unroll
                    for (int q = 0; q < 4; ++q)
#pragma unroll
                        for (int k = 0; k < 3; ++k) vv[q][k] = vs[(j4 + q) * 96 + dl + 32 * k];
#pragma unroll
                    for (int ii = 0; ii < 16; ++ii) {
                        const float4 w4 = *(const float4*)(wsm + (ig * 16 + ii) * 128 + j4);
#pragma unroll
                        for (int k = 0; k < 3; ++k) acc[ii][k] += w4.x * vv[0][k] + w4.y * vv[1][k] + w4.z * vv[2][k] + w4.w * vv[3][k];
                    }
                }
#pragma unroll
                for (int ii = 0; ii < 16; ++ii) {
                    const int i = ig * 16 + ii;
                    const float sb = sgu_b[h * 128 + i];
#pragma unroll
                    for (int k = 0; k < 3; ++k) {
                        const int ch = h * 96 + dl + 32 * k;
                        const float u = gelu_t(bf2f(Z[(rb + t0 + i) * DIN + 768 + ch]));
                        MIX[(rb + t0 + i) * D + 384 + ch] = f2bf(u * (acc[ii][k] + sb));
                    }
                }
                __syncthreads();
            }
        }
        {
            float* ps = (float*)smem;
            const int ch = tid, g = ch >> 6, w = 2 << g, o = tid & 63;
#pragma unroll 1
            for (int sb = 0; sb < 4; ++sb) {
                const int ts = t0 + sb * 32;
#pragma unroll 2
                for (int r = 0; r < 32; ++r) {
                    const int t = ts + r;
                    float s = 0.f;
#pragma unroll
                    for (int k = 0; k < 16; ++k) { const bool ok = (k < w) && (t - k >= 0); const float zv = bf2f(Z[(rb + (ok ? t - k : t)) * DIN + 1536 + ch]); s += ok ? zv : 0.f; }
                    const float cnt = (float)((t + 1) < w ? (t + 1) : w);
                    ps[r * 256 + ch] = s / cnt - bf2f(Z[(rb + t) * DIN + 1536 + ch]);
                }
                __syncthreads();
                float acc[32];
#pragma unroll
                for (int r = 0; r < 32; ++r) acc[r] = 0.f;
#pragma unroll 1
                for (int i = 0; i < 64; i += 4) {
                    const float w0 = pool_w[g * 4096 + (i + 0) * 64 + o], w1 = pool_w[g * 4096 + (i + 1) * 64 + o];
                    const float w2 = pool_w[g * 4096 + (i + 2) * 64 + o], w3 = pool_w[g * 4096 + (i + 3) * 64 + o];
#pragma unroll
                    for (int r = 0; r < 32; ++r) {
                        const float4 p4 = *(const float4*)(ps + r * 256 + g * 64 + i);
                        acc[r] += p4.x * w0 + p4.y * w1 + p4.z * w2 + p4.w * w3;
                    }
                }
                const float pb = pool_b[ch], sc = pool_scale[ch];
#pragma unroll
                for (int r = 0; r < 32; ++r) MIX[(rb + ts + r) * D + 768 + ch] = f2bf((acc[r] + pb) * sc);
                __syncthreads();
            }
        }
    }
}

struct Params { const float* in[31]; float* out; char* ws; };

constexpr size_t OFF_H = 1ull << 20;
constexpr size_t OFF_Z = OFF_H + (size_t)T * D * 2;
constexpr size_t OFF_MIX = OFF_Z + (size_t)T * DIN * 2;
constexpr size_t OFF_ACT = OFF_MIX + (size_t)T * D * 2;
constexpr size_t OFF_MN = OFF_ACT + (size_t)T * DFF * 2;
constexpr size_t OFF_KB = OFF_MN + (size_t)2048 * D * 2;
constexpr size_t OFF_VB = OFF_KB + (size_t)2048 * D * 2;
constexpr size_t OFF_LIST = OFF_VB + (size_t)2048 * D * 2;
constexpr size_t OFF_GATE = OFF_LIST + (size_t)NE * T * 4;

extern "C" __global__ __launch_bounds__(256) void mega(Params P) {
    extern __shared__ __attribute__((aligned(16))) char smem[];
    __shared__ uint4 xb_words;
    if (threadIdx.x == 0) xb_words = make_uint4(0u, 0u, 0u, 0u);
    __syncthreads();
    unsigned* bar = (unsigned*)P.ws;
    XcdBarrier xb = xcd_barrier_post(bar, (volatile LAS unsigned*)&xb_words);
    int* cnt = (int*)(P.ws + 16384);
    bf16_t* H = (bf16_t*)(P.ws + OFF_H);
    bf16_t* Z = (bf16_t*)(P.ws + OFF_Z);
    bf16_t* MIX = (bf16_t*)(P.ws + OFF_MIX);
    bf16_t* ACT = (bf16_t*)(P.ws + OFF_ACT);
    float* SC = (float*)(P.ws + OFF_ACT);
    bf16_t* Q = Z; bf16_t* PB = MIX; bf16_t* O = H;
    bf16_t* MN = (bf16_t*)(P.ws + OFF_MN);
    bf16_t* KB = (bf16_t*)(P.ws + OFF_KB);
    bf16_t* VB = (bf16_t*)(P.ws + OFF_VB);
    int* list = (int*)(P.ws + OFF_LIST);
    float* gatev = (float*)(P.ws + OFF_GATE);
    float* X = P.out;

    for (int l = 0; l < 2; ++l) {
        const float* Xsrc = (l == 0) ? P.in[0] : X;
        rmsnorm_phase<false, false>(Xsrc, P.in[2] + l * D, H, T, nullptr, nullptr, nullptr, nullptr);
        xcd_barrier(xb);
        { GemmP g{}; g.A = H; g.lda = D; g.B = P.in[3] + (long)l * D * DIN; g.ldb = DIN; g.M = T; g.N = DIN; g.K = D; g.nbatch = 1; g.C = Z; g.ldc = DIN;
          gemm<0, 0, false>(g, smem); }
        xcd_barrier(xb);
        mixer_phase(Z, MIX, smem, P.in[4] + l * 31 * 384, P.in[5] + l * 384, P.in[6] + l * 384, P.in[7] + l * 384,
                    P.in[8] + l * 384, P.in[9] + l * 384, P.in[10] + (long)l * 4 * 128 * 128, P.in[11] + l * 4 * 128,
                    P.in[12] + l * 4 * 64 * 64, P.in[13] + l * 256, P.in[14] + l * 256);
        xcd_barrier(xb);
        { GemmP g{}; g.A = MIX; g.lda = D; g.B = P.in[15] + (long)l * D * D; g.ldb = D; g.M = T; g.N = D; g.K = D; g.nbatch = 1; g.C = X; g.ldc = D; g.R = Xsrc;
          gemm<0, 2, false>(g, smem); }
        xcd_barrier(xb);
        rmsnorm_phase<false, false>(X, P.in[16] + l * D, H, T, nullptr, nullptr, nullptr, nullptr);
        rmsnorm_phase<false, false>(P.in[1], P.in[17] + l * D, MN, 2048, nullptr, nullptr, nullptr, nullptr);
        xcd_barrier(xb);
        { GemmP g{}; g.A = H; g.lda = D; g.B = P.in[18] + (long)l * D * D; g.ldb = D; g.M = T; g.N = D; g.K = D; g.nbatch = 1; g.C = Q; g.ldc = D;
          gemm<0, 0, false>(g, smem);
          g.A = MN; g.M = 2048; g.B = P.in[19] + (long)l * D * D; g.C = KB; gemm<0, 0, false>(g, smem);
          g.B = P.in[20] + (long)l * D * D; g.C = VB; gemm<0, 0, false>(g, smem); }
        xcd_barrier(xb);
        { GemmP g{}; g.A = Q; g.lda = D; g.B = KB; g.ldb = D; g.M = S; g.N = 256; g.K = 256; g.nbatch = 32;
          g.aB1 = (long)S * D; g.aB2 = 256; g.bB1 = 256L * D; g.bB2 = 256; g.cB1 = (long)S * D; g.cB2 = 256; g.C = SC; g.ldc = D; g.scale = 0.0625f;
          gemm<1, 1, false>(g, smem); }
        xcd_barrier(xb);
        softmax_phase(SC, PB);
        xcd_barrier(xb);
        { GemmP g{}; g.A = PB; g.lda = D; g.B = VB; g.ldb = D; g.M = S; g.N = 256; g.K = 256; g.nbatch = 32;
          g.aB1 = (long)S * D; g.aB2 = 256; g.bB1 = 256L * D; g.bB2 = 256; g.cB1 = (long)S * D; g.cB2 = 256; g.C = O; g.ldc = D;
          gemm<2, 0, false>(g, smem); }
        xcd_barrier(xb);
        { GemmP g{}; g.A = O; g.lda = D; g.B = P.in[21] + (long)l * D * D; g.ldb = D; g.M = T; g.N = D; g.K = D; g.nbatch = 1; g.C = X; g.ldc = D; g.R = X;
          gemm<0, 2, false>(g, smem); }
        xcd_barrier(xb);
        if (l == 0) rmsnorm_phase<false, false>(X, P.in[22] + l * D, H, T, nullptr, nullptr, nullptr, nullptr);
        else rmsnorm_phase<false, true>(X, P.in[22] + l * D, H, T, P.in[26], cnt, list, gatev);
        xcd_barrier(xb);
        if (l == 0) {
            { GemmP g{}; g.A = H; g.lda = D; g.B = P.in[23]; g.B2 = P.in[24]; g.ldb = DFF; g.M = T; g.N = DFF; g.K = D; g.nbatch = 1; g.C = ACT; g.ldc = DFF;
              gemm<0, 3, true>(g, smem); }
            xcd_barrier(xb);
            { GemmP g{}; g.A = ACT; g.lda = DFF; g.B = P.in[25]; g.ldb = D; g.M = T; g.N = D; g.K = DFF; g.nbatch = 1; g.C = X; g.ldc = D; g.R = X;
              gemm<0, 2, false>(g, smem); }
            xcd_barrier(xb);
        } else {
            for (int e = 0; e < NE; ++e) {
                const int Me = __hip_atomic_load(&cnt[e], __ATOMIC_RELAXED, __HIP_MEMORY_SCOPE_AGENT);
                { GemmP g{}; g.A = H; g.lda = D; g.gatherA = list + e * T; g.B = P.in[27] + (long)e * D * DFF; g.B2 = P.in[28] + (long)e * D * DFF; g.ldb = DFF;
                  g.M = Me; g.N = DFF; g.K = D; g.nbatch = 1; g.C = ACT; g.ldc = DFF;
                  if (Me > 0) gemm<0, 3, true>(g, smem); }
                xcd_barrier(xb);
                { GemmP g{}; g.A = ACT; g.lda = DFF; g.B = P.in[29] + (long)e * DFF * D; g.ldb = D; g.M = Me; g.N = D; g.K = DFF; g.nbatch = 1; g.C = X; g.ldc = D;
                  g.scatter = list + e * T; g.gate = gatev + e * T;
                  if (Me > 0) gemm<0, 4, false>(g, smem); }
                xcd_barrier(xb);
            }
        }
    }
    rmsnorm_phase<true, false>(X, P.in[30], X, T, nullptr, nullptr, nullptr, nullptr);
}

extern "C" void kernel_launch(void* const* d_in, const int* in_sizes, int n_in,
                              void* d_out, int out_size, void* d_ws, size_t ws_size,
                              hipStream_t stream) {
    Params p{};
    for (int i = 0; i < 31; ++i) p.in[i] = (const float*)d_in[i];
    p.out = (float*)d_out; p.ws = (char*)d_ws;
    hipFuncSetAttribute((const void*)mega, hipFuncAttributeMaxDynamicSharedMemorySize, LDS_BYTES);
    int dev = 0; hipGetDevice(&dev);
    int ncu = 256; hipDeviceGetAttribute(&ncu, hipDeviceAttributeMultiprocessorCount, dev);
    int per_cu = 0;
    if (hipOccupancyMaxActiveBlocksPerMultiprocessor(&per_cu, (const void*)mega, 256, LDS_BYTES) != hipSuccess || per_cu < 1) return;
    const int grid = ncu;
    hipMemsetAsync(d_ws, 0, 32768, stream);
    hipLaunchKernelGGL(mega, dim3(grid), dim3(256), LDS_BYTES, stream, p);
}
```

```cpp
#include <hip/hip_runtime.h>
#include <stdint.h>

#define XB_TMO      128
#define XB_XCNT(j)  (256  + 64 * (j))
#define XB_XSUB(j)  (1280 + 64 * (j))
#define XB_XGEN(j)  (2304 + 64 * (j))
#define XB_TOP      3328
#define XB_TOPGEN   3392
#define XCD_BAR_WORDS 3456
#define XB_SPIN_CAP (1u << 22)
#define LAS __attribute__((address_space(3)))

__device__ __forceinline__ unsigned xb_ld(unsigned* p)              { return __hip_atomic_load(p, __ATOMIC_RELAXED, __HIP_MEMORY_SCOPE_AGENT); }
__device__ __forceinline__ unsigned xb_add(unsigned* p, unsigned v) { return __hip_atomic_fetch_add(p, v, __ATOMIC_RELAXED, __HIP_MEMORY_SCOPE_AGENT); }
__device__ __forceinline__ unsigned xb_xcc_id() { return (unsigned)__builtin_amdgcn_s_getreg((3 << 11) | 20) & 0xFu; }
#define XB_SPIN(cond, bar) do { unsigned _sp = 0; while (cond) { __builtin_amdgcn_s_sleep(1); \
    if ((++_sp & 255u) == 0u) { if (xb_ld(&(bar)[XB_TMO])) break; if (_sp > XB_SPIN_CAP) { atomicAdd(&(bar)[XB_TMO], 1u); break; } } } } while (0)

struct XcdBarrier { unsigned* bar; unsigned x; volatile LAS unsigned* st; };

__device__ __forceinline__ XcdBarrier xcd_barrier_post(unsigned* bar, volatile LAS unsigned* st) {
    XcdBarrier b; b.bar = bar; b.x = xb_xcc_id(); b.st = st;
    if (threadIdx.x == 0) (void)xb_add(&bar[XB_XCNT(b.x)], 1u);
    return b;
}
__device__ __forceinline__ void xcd_barrier_complete(unsigned* bar, unsigned x, unsigned& nloc, unsigned& nx) {
    const unsigned G = gridDim.x * gridDim.y * gridDim.z;
    unsigned sum, cnt, mine, sp = 0u;
    for (;;) {
        sum = 0u; cnt = 0u; mine = 0u;
#pragma unroll
        for (unsigned j = 0; j < 16; ++j) { const unsigned c = xb_ld(&bar[XB_XCNT(j)]); sum += c; cnt += (c > 0u) ? 1u : 0u; mine = (j == x) ? c : mine; }
        if (sum == G) break;
        __builtin_amdgcn_s_sleep(1);
        if ((++sp & 255u) == 0u) { if (xb_ld(&bar[XB_TMO])) break; if (sp > XB_SPIN_CAP) { atomicAdd(&bar[XB_TMO], 1u); break; } }
    }
    nloc = mine > 0u ? mine : 1u; nx = cnt > 0u ? cnt : 1u;
}
__device__ __forceinline__ void xcd_barrier(const XcdBarrier& b) {
    asm volatile("s_waitcnt vmcnt(0)" ::: "memory");
    __syncthreads();
    if (threadIdx.x == 0) {
        unsigned* bar = b.bar;
        __builtin_amdgcn_s_waitcnt(0);
        unsigned nloc = b.st[0], nx = b.st[1];
        if (nloc == 0u) { xcd_barrier_complete(bar, b.x, nloc, nx); b.st[0] = nloc; b.st[1] = nx; }
        const unsigned old = xb_add(&bar[XB_XSUB(b.x)], 1u);
        const unsigned gen = old / nloc;
        if (old + 1u == (gen + 1u) * nloc) {
            __builtin_amdgcn_fence(__ATOMIC_RELEASE, "agent");
            asm volatile("s_waitcnt vmcnt(0)" ::: "memory");
            const unsigned og = xb_add(&bar[XB_TOP], 1u);
            const unsigned tg = og / nx;
            if (og + 1u == (tg + 1u) * nx) xb_add(&bar[XB_TOPGEN], 1u);
            else XB_SPIN(xb_ld(&bar[XB_TOPGEN]) == tg, bar);
            __builtin_amdgcn_fence(__ATOMIC_ACQUIRE, "agent");
            xb_add(&bar[XB_XGEN(b.x)], 1u);
            asm volatile("s_waitcnt vmcnt(0)" ::: "memory");
        } else {
            XB_SPIN(xb_ld(&bar[XB_XGEN(b.x)]) == gen, bar);
            __builtin_amdgcn_fence(__ATOMIC_ACQUIRE, "agent");
            asm volatile("s_waitcnt vmcnt(0)" ::: "memory");
        }
    }
    __syncthreads();
}

typedef unsigned short bf16_t;
typedef short s16x4 __attribute__((ext_vector_type(4)));
typedef short s16x8 __attribute__((ext_vector_type(8)));
typedef __bf16 bf16x8_t __attribute__((ext_vector_type(8)));
typedef float f32x16 __attribute__((ext_vector_type(16)));

__device__ __forceinline__ bf16_t f2bf(float f) { unsigned u = __float_as_uint(f); u += 0x7fffu + ((u >> 16) & 1u); return (bf16_t)(u >> 16); }
__device__ __forceinline__ float bf2f(bf16_t h) { return __uint_as_float(((unsigned)h) << 16); }
__device__ __forceinline__ unsigned pack2(float a, float b) { return (unsigned)f2bf(a) | ((unsigned)f2bf(b) << 16); }
__device__ __forceinline__ float wsum(float v) {
#pragma unroll
    for (int o = 32; o > 0; o >>= 1) v += __shfl_xor(v, o, 64);
    return v;
}
__device__ __forceinline__ float wmax(float v) {
#pragma unroll
    for (int o = 32; o > 0; o >>= 1) v = fmaxf(v, __shfl_xor(v, o, 64));
    return v;
}
__device__ __forceinline__ float gelu_t(float x) { return 0.5f * x * (1.f + tanhf(0.7978845608028654f * (x + 0.044715f * x * x * x))); }
__device__ __forceinline__ float sigm(float x) { return 1.f / (1.f + __expf(-x)); }

constexpr int T = 32768, D = 1024, S = 4096, DIN = 1792, DFF = 2816, NE = 8;
constexpr int LDS_BYTES = 65536 + 49152 + 1024;

struct GemmP {
    const bf16_t* A; long lda; const int* gatherA;
    const void* B; const void* B2; long ldb;
    int M, N, K, nbatch;
    long aB1, aB2, bB1, bB2, cB1, cB2;
    void* C; long ldc; const float* R; float scale; const int* scatter; const float* gate;
};
template <int BMODE, int EPI, bool DUAL>
__device__ __forceinline__ void gemm(const GemmP& p, char* smem) {
    constexpr int LS = 72;
    bf16_t* sA = (bf16_t*)smem;
    bf16_t* sB = sA + 128 * LS;
    int tid = threadIdx.x; asm volatile("" : "+v"(tid));
    const int lane = tid & 63, wave = tid >> 6, wr = wave >> 1, wc = wave & 1;
    const int mt = (p.M + 127) >> 7, nt = p.N >> 7, per = mt * nt, total = per * p.nbatch, nk = p.K >> 6;
    const int G = gridDim.x, bp = (G & 7) ? (int)blockIdx.x : (int)((blockIdx.x & 7) * (G >> 3) + (blockIdx.x >> 3));
    for (int tbase = 0; tbase < total; tbase += G) {
        const int tile = tbase + bp;
        if (tile >= total) continue;
        const int batch = tile / per, rem = tile - batch * per;
        const int grp = rem / (4 * mt), gsz = (nt - 4 * grp) < 4 ? (nt - 4 * grp) : 4, gi = rem - grp * 4 * mt, tm = gi / gsz, tn = 4 * grp + (gi - tm * gsz);
        const long aoff = (long)(batch >> 2) * p.aB1 + (long)(batch & 3) * p.aB2;
        const long boff = (long)(batch >> 2) * p.bB1 + (long)(batch & 3) * p.bB2;
        const long coff = (long)(batch >> 2) * p.cB1 + (long)(batch & 3) * p.cB2;
        const bf16_t *arow0, *arow1, *arow2, *arow3;
        {
            int r0 = tm * 128 + (tid >> 3), r1 = r0 + 32, r2 = r0 + 64, r3 = r0 + 96;
            if (r0 >= p.M) r0 = p.M - 1; if (r1 >= p.M) r1 = p.M - 1; if (r2 >= p.M) r2 = p.M - 1; if (r3 >= p.M) r3 = p.M - 1;
            const long s0 = p.gatherA ? (long)p.gatherA[r0] : (long)r0, s1 = p.gatherA ? (long)p.gatherA[r1] : (long)r1;
            const long s2 = p.gatherA ? (long)p.gatherA[r2] : (long)r2, s3 = p.gatherA ? (long)p.gatherA[r3] : (long)r3;
            const bf16_t* ab = p.A + aoff + (tid & 7) * 8;
            arow0 = ab + s0 * p.lda; arow1 = ab + s1 * p.lda; arow2 = ab + s2 * p.lda; arow3 = ab + s3 * p.lda;
        }
        uint4 ar0, ar1, ar2, ar3;
        float bfv[DUAL ? 64 : 32];
        unsigned bu[32];
        const int bn = tid & 127, bkh = tid >> 7;
        auto loadg = [&](int kt) {
            const int k0 = kt * 64;
            ar0 = *(const uint4*)(arow0 + k0); ar1 = *(const uint4*)(arow1 + k0); ar2 = *(const uint4*)(arow2 + k0); ar3 = *(const uint4*)(arow3 + k0);
            if constexpr (BMODE == 0) {
                const float* Bp = (const float*)p.B + boff + tn * 128 + bn;
#pragma unroll
                for (int j = 0; j < 8; ++j)
#pragma unroll
                    for (int q = 0; q < 4; ++q) bfv[j * 4 + q] = Bp[(long)(k0 + (bkh + 2 * j) * 4 + q) * p.ldb];
                if constexpr (DUAL) {
                    const float* Bq = (const float*)p.B2 + boff + tn * 128 + bn;
#pragma unroll
                    for (int j = 0; j < 8; ++j)
#pragma unroll
                        for (int q = 0; q < 4; ++q) bfv[32 + j * 4 + q] = Bq[(long)(k0 + (bkh + 2 * j) * 4 + q) * p.ldb];
                }
            } else if constexpr (BMODE == 1) {
                const bf16_t* Bp = (const bf16_t*)p.B + boff + (long)(tn * 128 + (tid >> 1)) * p.ldb + k0 + (tid & 1) * 32;
#pragma unroll
                for (int j = 0; j < 4; ++j) { const uint4 v = *(const uint4*)(Bp + j * 8); bu[j * 4] = v.x; bu[j * 4 + 1] = v.y; bu[j * 4 + 2] = v.z; bu[j * 4 + 3] = v.w; }
            } else {
                const bf16_t* Bp = (const bf16_t*)p.B + boff + tn * 128 + bn;
#pragma unroll
                for (int j = 0; j < 8; ++j)
#pragma unroll
                    for (int q = 0; q < 4; ++q) bu[j * 4 + q] = Bp[(long)(k0 + (bkh + 2 * j) * 4 + q) * p.ldb];
            }
        };
        auto stores = [&]() {
            bf16_t* da = sA + (tid >> 3) * LS + (tid & 7) * 8;
            *(uint4*)da = ar0; *(uint4*)(da + 32 * LS) = ar1; *(uint4*)(da + 64 * LS) = ar2; *(uint4*)(da + 96 * LS) = ar3;
            if constexpr (BMODE == 0) {
#pragma unroll
                for (int j = 0; j < 8; ++j) {
                    uint2 v; v.x = pack2(bfv[j * 4], bfv[j * 4 + 1]); v.y = pack2(bfv[j * 4 + 2], bfv[j * 4 + 3]);
                    *(uint2*)(sB + bn * LS + (bkh + 2 * j) * 4) = v;
                    if constexpr (DUAL) {
                        uint2 w; w.x = pack2(bfv[32 + j * 4], bfv[32 + j * 4 + 1]); w.y = pack2(bfv[32 + j * 4 + 2], bfv[32 + j * 4 + 3]);
                        *(uint2*)(sB + (128 + bn) * LS + (bkh + 2 * j) * 4) = w;
                    }
                }
            } else if constexpr (BMODE == 1) {
                bf16_t* d = sB + (tid >> 1) * LS + (tid & 1) * 32;
#pragma unroll
                for (int j = 0; j < 4; ++j) { uint4 v; v.x = bu[j * 4]; v.y = bu[j * 4 + 1]; v.z = bu[j * 4 + 2]; v.w = bu[j * 4 + 3]; *(uint4*)(d + j * 8) = v; }
            } else {
#pragma unroll
                for (int j = 0; j < 8; ++j) {
                    uint2 v; v.x = bu[j * 4] | (bu[j * 4 + 1] << 16); v.y = bu[j * 4 + 2] | (bu[j * 4 + 3] << 16);
                    *(uint2*)(sB + bn * LS + (bkh + 2 * j) * 4) = v;
                }
            }
        };
        f32x16 acc[2][2], acc2[2][2];
#pragma unroll
        for (int a = 0; a < 2; ++a)
#pragma unroll
            for (int b = 0; b < 2; ++b)
#pragma unroll
                for (int i = 0; i < 16; ++i) { acc[a][b][i] = 0.f; acc2[a][b][i] = 0.f; }
        loadg(0);
#pragma unroll 1
        for (int kt = 0; kt < nk; ++kt) {
            __syncthreads();
            stores();
            __syncthreads();
            if (kt + 1 < nk) loadg(kt + 1);
#pragma unroll
            for (int ks = 0; ks < 4; ++ks) {
                const int kk = ks * 16 + (lane >> 5) * 8;
                s16x8 af[2], bfr[2], bf2[2];
#pragma unroll
                for (int mi = 0; mi < 2; ++mi) af[mi] = *(const s16x8*)(sA + (wr * 64 + mi * 32 + (lane & 31)) * LS + kk);
#pragma unroll
                for (int ni = 0; ni < 2; ++ni) {
                    bfr[ni] = *(const s16x8*)(sB + (wc * 64 + ni * 32 + (lane & 31)) * LS + kk);
                    if constexpr (DUAL) bf2[ni] = *(const s16x8*)(sB + (128 + wc * 64 + ni * 32 + (lane & 31)) * LS + kk);
                }
#pragma unroll
                for (int mi = 0; mi < 2; ++mi)
#pragma unroll
                    for (int ni = 0; ni < 2; ++ni) {
                        acc[mi][ni] = __builtin_amdgcn_mfma_f32_32x32x16_bf16(__builtin_bit_cast(bf16x8_t, af[mi]), __builtin_bit_cast(bf16x8_t, bfr[ni]), acc[mi][ni], 0, 0, 0);
                        if constexpr (DUAL) acc2[mi][ni] = __builtin_amdgcn_mfma_f32_32x32x16_bf16(__builtin_bit_cast(bf16x8_t, af[mi]), __builtin_bit_cast(bf16x8_t, bf2[ni]), acc2[mi][ni], 0, 0, 0);
                    }
            }
        }
#pragma unroll
        for (int mi = 0; mi < 2; ++mi)
#pragma unroll
            for (int ni = 0; ni < 2; ++ni)
#pragma unroll
                for (int i = 0; i < 16; ++i) {
                    const int r = tm * 128 + wr * 64 + mi * 32 + (i >> 2) * 8 + (lane >> 5) * 4 + (i & 3);
                    const int c = tn * 128 + wc * 64 + ni * 32 + (lane & 31);
                    if (r < p.M) {
                        const float v = acc[mi][ni][i];
                        const long idx = coff + (long)r * p.ldc + c;
                        if constexpr (EPI == 0) ((bf16_t*)p.C)[idx] = f2bf(v);
                        else if constexpr (EPI == 1) ((float*)p.C)[idx] = v * p.scale;
                        else if constexpr (EPI == 2) ((float*)p.C)[idx] = p.R[idx] + v;
                        else if constexpr (EPI == 3) { const float u = acc2[mi][ni][i]; ((bf16_t*)p.C)[idx] = f2bf(v * sigm(v) * u); }
                        else { const long tk = p.scatter[r]; float* x = (float*)p.C + tk * p.ldc + c; *x = *x + p.gate[r] * v; }
                    }
                }
    }
}

template <bool OUTF, bool ROUTER>
__device__ __forceinline__ void rmsnorm_phase(const float* X, const float* g, void* out, int rows,
                                              const float* rw, int* cnt, int* list, float* gatev) {
    int tid = threadIdx.x; asm volatile("" : "+v"(tid));
    const int lane = tid & 63, wave = tid >> 6;
    for (int row = blockIdx.x * 4 + wave; row < rows; row += gridDim.x * 4) {
        const float* xr = X + (long)row * D;
        float4 v[4]; float ss = 0.f;
#pragma unroll
        for (int j = 0; j < 4; ++j) { v[j] = *(const float4*)(xr + (j * 64 + lane) * 4); ss += v[j].x * v[j].x + v[j].y * v[j].y + v[j].z * v[j].z + v[j].w * v[j].w; }
        ss = wsum(ss);
        const float rs = rsqrtf(ss * (1.f / D) + 1e-6f);
        float lg[NE];
        if constexpr (ROUTER) {
#pragma unroll
            for (int e = 0; e < NE; ++e) lg[e] = 0.f;
        }
#pragma unroll
        for (int j = 0; j < 4; ++j) {
            const int c = (j * 64 + lane) * 4;
            const float4 gg = *(const float4*)(g + c);
            float4 y; y.x = v[j].x * rs * gg.x; y.y = v[j].y * rs * gg.y; y.z = v[j].z * rs * gg.z; y.w = v[j].w * rs * gg.w;
            if constexpr (OUTF) *(float4*)((float*)out + (long)row * D + c) = y;
            else { uint2 pk; pk.x = pack2(y.x, y.y); pk.y = pack2(y.z, y.w); *(uint2*)((bf16_t*)out + (long)row * D + c) = pk; }
            if constexpr (ROUTER) {
                const float4 r0 = *(const float4*)(rw + (long)c * NE), r1 = *(const float4*)(rw + (long)c * NE + 4);
                const float4 r2 = *(const float4*)(rw + (long)(c + 1) * NE), r3 = *(const float4*)(rw + (long)(c + 1) * NE + 4);
                const float4 r4 = *(const float4*)(rw + (long)(c + 2) * NE), r5 = *(const float4*)(rw + (long)(c + 2) * NE + 4);
                const float4 r6 = *(const float4*)(rw + (long)(c + 3) * NE), r7 = *(const float4*)(rw + (long)(c + 3) * NE + 4);
                lg[0] += y.x * r0.x + y.y * r2.x + y.z * r4.x + y.w * r6.x; lg[1] += y.x * r0.y + y.y * r2.y + y.z * r4.y + y.w * r6.y;
                lg[2] += y.x * r0.z + y.y * r2.z + y.z * r4.z + y.w * r6.z; lg[3] += y.x * r0.w + y.y * r2.w + y.z * r4.w + y.w * r6.w;
                lg[4] += y.x * r1.x + y.y * r3.x + y.z * r5.x + y.w * r7.x; lg[5] += y.x * r1.y + y.y * r3.y + y.z * r5.y + y.w * r7.y;
                lg[6] += y.x * r1.z + y.y * r3.z + y.z * r5.z + y.w * r7.z; lg[7] += y.x * r1.w + y.y * r3.w + y.z * r5.w + y.w * r7.w;
            }
        }
        if constexpr (ROUTER) {
#pragma unroll
            for (int e = 0; e < NE; ++e) lg[e] = wsum(lg[e]);
            if (lane == 0) {
                int i0 = 0; float v0 = lg[0];
#pragma unroll
                for (int e = 1; e < NE; ++e) if (lg[e] > v0) { v0 = lg[e]; i0 = e; }
                int i1 = -1; float v1 = -3.0e38f;
#pragma unroll
                for (int e = 0; e < NE; ++e) if (e != i0 && lg[e] > v1) { v1 = lg[e]; i1 = e; }
                const float e1 = __expf(v1 - v0), g0 = 1.f / (1.f + e1), g1 = e1 / (1.f + e1);
                const int s0 = atomicAdd(&cnt[i0], 1); list[i0 * T + s0] = row; gatev[i0 * T + s0] = g0;
                const int s1 = atomicAdd(&cnt[i1], 1); list[i1 * T + s1] = row; gatev[i1 * T + s1] = g1;
            }
        }
    }
}

__device__ __forceinline__ void softmax_phase(const float* Sc, bf16_t* P) {
    int tid = threadIdx.x; asm volatile("" : "+v"(tid));
    const int lane = tid & 63, wave = tid >> 6;
    for (int it = blockIdx.x * 4 + wave; it < T * 4; it += gridDim.x * 4) {
        const float4 v = *(const float4*)(Sc + (long)it * 256 + lane * 4);
        const float m = wmax(fmaxf(fmaxf(v.x, v.y), fmaxf(v.z, v.w)));
        const float e0 = __expf(v.x - m), e1 = __expf(v.y - m), e2 = __expf(v.z - m), e3 = __expf(v.w - m);
        const float inv = 1.f / wsum(e0 + e1 + e2 + e3);
        uint2 pk; pk.x = pack2(e0 * inv, e1 * inv); pk.y = pack2(e2 * inv, e3 * inv);
        *(uint2*)(P + (long)it * 256 + lane * 4) = pk;
    }
}

__device__ __forceinline__ void mixer_phase(const bf16_t* Z, bf16_t* MIX, char* smem,
        const float* conv_w, const float* conv_b, const float* cln_g, const float* cln_b,
        const float* sln_g, const float* sln_b, const float* sgu_w, const float* sgu_b,
        const float* pool_w, const float* pool_b, const float* pool_scale) {
    int tid = threadIdx.x; asm volatile("" : "+v"(tid));
    const int lane = tid & 63, wave = tid >> 6;
    for (int unit = blockIdx.x; unit < 256; unit += gridDim.x) {
        const int b = unit >> 5, t0 = (unit & 31) * 128;
        const long rb = (long)b * S;
        {
            float* hs = (float*)smem;
            float* ys = hs + 46 * 384;
#pragma unroll 1
            for (int sb = 0; sb < 8; ++sb) {
                const int ts = t0 + sb * 16;
#pragma unroll 3
                for (int idx = tid; idx < 46 * 384; idx += 256) {
                    const int r = idx / 384, c = idx - r * 384, t = ts - 30 + r;
                    float v = 0.f;
                    if (t >= 0) { const bf16_t* zr = Z + (rb + t) * DIN; v = bf2f(zr[c]) * sigm(bf2f(zr[384 + c])); }
                    hs[idx] = v;
                }
                __syncthreads();
                const int pg = tid >> 7, cl = tid & 127;
#pragma unroll 1
                for (int k = 0; k < 3; ++k) {
                    const int c = cl + 128 * k;
                    float w[31];
#pragma unroll
                    for (int j = 0; j < 31; ++j) w[j] = conv_w[j * 384 + c];
                    float acc[8];
                    const float cb = conv_b[c];
#pragma unroll
                    for (int q = 0; q < 8; ++q) acc[q] = cb;
#pragma unroll
                    for (int i = 0; i < 38; ++i) {
                        const float hv = hs[(pg * 8 + i) * 384 + c];
#pragma unroll
                        for (int q = 0; q < 8; ++q) { if (i - q >= 0 && i - q <= 30) acc[q] += w[i - q] * hv; }
                    }
#pragma unroll
                    for (int q = 0; q < 8; ++q) ys[(pg * 8 + q) * 384 + c] = acc[q];
                }
                __syncthreads();
#pragma unroll
                for (int rr = 0; rr < 4; ++rr) {
                    const int r = wave * 4 + rr;
                    float v[6]; float s = 0.f;
#pragma unroll
                    for (int q = 0; q < 6; ++q) { v[q] = ys[r * 384 + lane + 64 * q]; s += v[q]; }
                    const float mean = wsum(s) * (1.f / 384.f);
                    float s2 = 0.f;
#pragma unroll
                    for (int q = 0; q < 6; ++q) { const float d = v[q] - mean; s2 += d * d; }
                    const float rstd = rsqrtf(wsum(s2) * (1.f / 384.f) + 1e-6f);
#pragma unroll
                    for (int q = 0; q < 6; ++q) {
                        const int c = lane + 64 * q;
                        const float y = (v[q] - mean) * rstd * cln_g[c] + cln_b[c];
                        MIX[(rb + ts + r) * D + c] = f2bf(y * sigm(y));
                    }
                }
                __syncthreads();
            }
        }
        {
            float* wsm = (float*)smem;
            float* vs = wsm + 128 * 128;
            float* st = vs + 128 * 96;
#pragma unroll 4
            for (int rr = 0; rr < 32; ++rr) {
                const int r = wave * 32 + rr;
                const bf16_t* zr = Z + (rb + t0 + r) * DIN + 1152;
                float v[6]; float s = 0.f;
#pragma unroll
                for (int q = 0; q < 6; ++q) { v[q] = gelu_t(bf2f(zr[lane + 64 * q])); s += v[q]; }
                const float mean = wsum(s) * (1.f / 384.f);
                float s2 = 0.f;
#pragma unroll
                for (int q = 0; q < 6; ++q) { const float d = v[q] - mean; s2 += d * d; }
                const float rstd = rsqrtf(wsum(s2) * (1.f / 384.f) + 1e-6f);
                if (lane == 0) { st[r] = mean; st[128 + r] = rstd; }
            }
            __syncthreads();
#pragma unroll 1
            for (int h = 0; h < 4; ++h) {
                const float4* wsrc = (const float4*)(sgu_w + (long)h * 128 * 128);
                for (int idx = tid; idx < 128 * 32; idx += 256) ((float4*)wsm)[idx] = wsrc[idx];
#pragma unroll 4
                for (int idx = tid; idx < 128 * 96; idx += 256) {
                    const int r = idx / 96, d = idx - r * 96, ch = h * 96 + d;
                    const float v = gelu_t(bf2f(Z[(rb + t0 + r) * DIN + 1152 + ch]));
                    vs[idx] = (v - st[r]) * st[128 + r] * sln_g[ch] + sln_b[ch];
                }
                __syncthreads();
                const int ig = tid >> 5, dl = tid & 31, jmax = ig < 4 ? 64 : 128;
                float acc[16][3];
#pragma unroll
                for (int ii = 0; ii < 16; ++ii) { acc[ii][0] = 0.f; acc[ii][1] = 0.f; acc[ii][2] = 0.f; }
#pragma unroll 1
                for (int j4 = 0; j4 < jmax; j4 += 4) {
                    float vv[4][3];
#pragma unroll
                    for (int q = 0; q < 4; ++q)
#pragma unroll
                        for (int k = 0; k < 3; ++k) vv[q][k] = vs[(j4 + q) * 96 + dl + 32 * k];
#pragma unroll
                    for (int ii = 0; ii < 16; ++ii) {
                        const float4 w4 = *(const float4*)(wsm + (ig * 16 + ii) * 128 + j4);
#pragma unroll
                        for (int k = 0; k < 3; ++k) acc[ii][k] += w4.x * vv[0][k] + w4.y * vv[1][k] + w4.z * vv[2][k] + w4.w * vv[3][k];
                    }
                }
#pragma unroll
                for (int ii = 0; ii < 16; ++ii) {
                    const int i = ig * 16 + ii;
                    const float sb = sgu_b[h * 128 + i];
#pragma unroll
                    for (int k = 0; k < 3; ++k) {
                        const int ch = h * 96 + dl + 32 * k;
                        const float u = gelu_t(bf2f(Z[(rb + t0 + i) * DIN + 768 + ch]));
                        MIX[(rb + t0 + i) * D + 384 + ch] = f2bf(u * (acc[ii][k] + sb));
                    }
                }
                __syncthreads();
            }
        }
        {
            float* ps = (float*)smem;
            const int ch = tid, g = ch >> 6, w = 2 << g, o = tid & 63;
#pragma unroll 1
            for (int sb = 0; sb < 4; ++sb) {
                const int ts = t0 + sb * 32;
#pragma unroll 2
                for (int r = 0; r < 32; ++r) {
                    const int t = ts + r;
                    float s = 0.f;
#pragma unroll
                    for (int k = 0; k < 16; ++k) { const bool ok = (k < w) && (t - k >= 0); const float zv = bf2f(Z[(rb + (ok ? t - k : t)) * DIN + 1536 + ch]); s += ok ? zv : 0.f; }
                    const float cnt = (float)((t + 1) < w ? (t + 1) : w);
                    ps[r * 256 + ch] = s / cnt - bf2f(Z[(rb + t) * DIN + 1536 + ch]);
                }
                __syncthreads();
                float acc[32];
#pragma unroll
                for (int r = 0; r < 32; ++r) acc[r] = 0.f;
#pragma unroll 1
                for (int i = 0; i < 64; i += 4) {
                    const float w0 = pool_w[g * 4096 + (i + 0) * 64 + o], w1 = pool_w[g * 4096 + (i + 1) * 64 + o];
                    const float w2 = pool_w[g * 4096 + (i + 2) * 64 + o], w3 = pool_w[g * 4096 + (i + 3) * 64 + o];
#pragma unroll
                    for (int r = 0; r < 32; ++r) {
                        const float4 p4 = *(const float4*)(ps + r * 256 + g * 64 + i);
                        acc[r] += p4.x * w0 + p4.y * w1 + p4.z * w2 + p4.w * w3;
                    }
                }
                const float pb = pool_b[ch], sc = pool_scale[ch];
#pragma unroll
                for (int r = 0; r < 32; ++r) MIX[(rb + ts + r) * D + 768 + ch] = f2bf((acc[r] + pb) * sc);
                __syncthreads();
            }
        }
    }
}

struct Params { const float* in[31]; float* out; char* ws; };

constexpr size_t OFF_H = 1ull << 20;
constexpr size_t OFF_Z = OFF_H + (size_t)T * D * 2;
constexpr size_t OFF_MIX = OFF_Z + (size_t)T * DIN * 2;
constexpr size_t OFF_ACT = OFF_MIX + (size_t)T * D * 2;
constexpr size_t OFF_MN = OFF_ACT + (size_t)T * DFF * 2;
constexpr size_t OFF_KB = OFF_MN + (size_t)2048 * D * 2;
constexpr size_t OFF_VB = OFF_KB + (size_t)2048 * D * 2;
constexpr size_t OFF_LIST = OFF_VB + (size_t)2048 * D * 2;
constexpr size_t OFF_GATE = OFF_LIST + (size_t)NE * T * 4;

extern "C" __global__ __launch_bounds__(256) void mega(Params P) {
    extern __shared__ __attribute__((aligned(16))) char smem[];
    __shared__ uint4 xb_words;
    if (threadIdx.x == 0) xb_words = make_uint4(0u, 0u, 0u, 0u);
    __syncthreads();
    unsigned* bar = (unsigned*)P.ws;
    XcdBarrier xb = xcd_barrier_post(bar, (volatile LAS unsigned*)&xb_words);
    int* cnt = (int*)(P.ws + 16384);
    bf16_t* H = (bf16_t*)(P.ws + OFF_H);
    bf16_t* Z = (bf16_t*)(P.ws + OFF_Z);
    bf16_t* MIX = (bf16_t*)(P.ws + OFF_MIX);
    bf16_t* ACT = (bf16_t*)(P.ws + OFF_ACT);
    float* SC = (float*)(P.ws + OFF_ACT);
    bf16_t* Q = Z; bf16_t* PB = MIX; bf16_t* O = H;
    bf16_t* MN = (bf16_t*)(P.ws + OFF_MN);
    bf16_t* KB = (bf16_t*)(P.ws + OFF_KB);
    bf16_t* VB = (bf16_t*)(P.ws + OFF_VB);
    int* list = (int*)(P.ws + OFF_LIST);
    float* gatev = (float*)(P.ws + OFF_GATE);
    float* X = P.out;

    for (int l = 0; l < 2; ++l) {
        const float* Xsrc = (l == 0) ? P.in[0] : X;
        rmsnorm_phase<false, false>(Xsrc, P.in[2] + l * D, H, T, nullptr, nullptr, nullptr, nullptr);
        xcd_barrier(xb);
        { GemmP g{}; g.A = H; g.lda = D; g.B = P.in[3] + (long)l * D * DIN; g.ldb = DIN; g.M = T; g.N = DIN; g.K = D; g.nbatch = 1; g.C = Z; g.ldc = DIN;
          gemm<0, 0, false>(g, smem); }
        xcd_barrier(xb);
        mixer_phase(Z, MIX, smem, P.in[4] + l * 31 * 384, P.in[5] + l * 384, P.in[6] + l * 384, P.in[7] + l * 384,
                    P.in[8] + l * 384, P.in[9] + l * 384, P.in[10] + (long)l * 4 * 128 * 128, P.in[11] + l * 4 * 128,
                    P.in[12] + l * 4 * 64 * 64, P.in[13] + l * 256, P.in[14] + l * 256);
        xcd_barrier(xb);
        { GemmP g{}; g.A = MIX; g.lda = D; g.B = P.in[15] + (long)l * D * D; g.ldb = D; g.M = T; g.N = D; g.K = D; g.nbatch = 1; g.C = X; g.ldc = D; g.R = Xsrc;
          gemm<0, 2, false>(g, smem); }
        xcd_barrier(xb);
        rmsnorm_phase<false, false>(X, P.in[16] + l * D, H, T, nullptr, nullptr, nullptr, nullptr);
        rmsnorm_phase<false, false>(P.in[1], P.in[17] + l * D, MN, 2048, nullptr, nullptr, nullptr, nullptr);
        xcd_barrier(xb);
        { GemmP g{}; g.A = H; g.lda = D; g.B = P.in[18] + (long)l * D * D; g.ldb = D; g.M = T; g.N = D; g.K = D; g.nbatch = 1; g.C = Q; g.ldc = D;
          gemm<0, 0, false>(g, smem);
          g.A = MN; g.M = 2048; g.B = P.in[19] + (long)l * D * D; g.C = KB; gemm<0, 0, false>(g, smem);
          g.B = P.in[20] + (long)l * D * D; g.C = VB; gemm<0, 0, false>(g, smem); }
        xcd_barrier(xb);
        { GemmP g{}; g.A = Q; g.lda = D; g.B = KB; g.ldb = D; g.M = S; g.N = 256; g.K = 256; g.nbatch = 32;
          g.aB1 = (long)S * D; g.aB2 = 256; g.bB1 = 256L * D; g.bB2 = 256; g.cB1 = (long)S * D; g.cB2 = 256; g.C = SC; g.ldc = D; g.scale = 0.0625f;
          gemm<1, 1, false>(g, smem); }
        xcd_barrier(xb);
        softmax_phase(SC, PB);
        xcd_barrier(xb);
        { GemmP g{}; g.A = PB; g.lda = D; g.B = VB; g.ldb = D; g.M = S; g.N = 256; g.K = 256; g.nbatch = 32;
          g.aB1 = (long)S * D; g.aB2 = 256; g.bB1 = 256L * D; g.bB2 = 256; g.cB1 = (long)S * D; g.cB2 = 256; g.C = O; g.ldc = D;
          gemm<2, 0, false>(g, smem); }
        xcd_barrier(xb);
        { GemmP g{}; g.A = O; g.lda = D; g.B = P.in[21] + (long)l * D * D; g.ldb = D; g.M = T; g.N = D; g.K = D; g.nbatch = 1; g.C = X; g.ldc = D; g.R = X;
          gemm<0, 2, false>(g, smem); }
        xcd_barrier(xb);
        if (l == 0) rmsnorm_phase<false, false>(X, P.in[22] + l * D, H, T, nullptr, nullptr, nullptr, nullptr);
        else rmsnorm_phase<false, true>(X, P.in[22] + l * D, H, T, P.in[26], cnt, list, gatev);
        xcd_barrier(xb);
        if (l == 0) {
            { GemmP g{}; g.A = H; g.lda = D; g.B = P.in[23]; g.B2 = P.in[24]; g.ldb = DFF; g.M = T; g.N = DFF; g.K = D; g.nbatch = 1; g.C = ACT; g.ldc = DFF;
              gemm<0, 3, true>(g, smem); }
            xcd_barrier(xb);
            { GemmP g{}; g.A = ACT; g.lda = DFF; g.B = P.in[25]; g.ldb = D; g.M = T; g.N = D; g.K = DFF; g.nbatch = 1; g.C = X; g.ldc = D; g.R = X;
              gemm<0, 2, false>(g, smem); }
            xcd_barrier(xb);
        } else {
            for (int e = 0; e < NE; ++e) {
                const int Me = __hip_atomic_load(&cnt[e], __ATOMIC_RELAXED, __HIP_MEMORY_SCOPE_AGENT);
                { GemmP g{}; g.A = H; g.lda = D; g.gatherA = list + e * T; g.B = P.in[27] + (long)e * D * DFF; g.B2 = P.in[28] + (long)e * D * DFF; g.ldb = DFF;
                  g.M = Me; g.N = DFF; g.K = D; g.nbatch = 1; g.C = ACT; g.ldc = DFF;
                  if (Me > 0) gemm<0, 3, true>(g, smem); }
                xcd_barrier(xb);
                { GemmP g{}; g.A = ACT; g.lda = DFF; g.B = P.in[29] + (long)e * DFF * D; g.ldb = D; g.M = Me; g.N = D; g.K = DFF; g.nbatch = 1; g.C = X; g.ldc = D;
                  g.scatter = list + e * T; g.gate = gatev + e * T;
                  if (Me > 0) gemm<0, 4, false>(g, smem); }
                xcd_barrier(xb);
            }
        }
    }
    rmsnorm_phase<true, false>(X, P.in[30], X, T, nullptr, nullptr, nullptr, nullptr);
}

extern "C" void kernel_launch(void* const* d_in, const int* in_sizes, int n_in,
                              void* d_out, int out_size, void* d_ws, size_t ws_size,
                              hipStream_t stream) {
    Params p{};
    for (int i = 0; i < 31; ++i) p.in[i] = (const float*)d_in[i];
    p.out = (float*)d_out; p.ws = (char*)d_ws;
    hipFuncSetAttribute((const void*)mega, hipFuncAttributeMaxDynamicSharedMemorySize, LDS_BYTES);
    int dev = 0; hipGetDevice(&dev);
    int ncu = 256; hipDeviceGetAttribute(&ncu, hipDeviceAttributeMultiprocessorCount, dev);
    int per_cu = 0;
    if (hipOccupancyMaxActiveBlocksPerMultiprocessor(&per_cu, (const void*)mega, 256, LDS_BYTES) != hipSuccess || per_cu < 1) return;
    const int grid = ncu;
    hipMemsetAsync(d_ws, 0, 32768, stream);
    hipLaunchKernelGGL(mega, dim3(grid), dim3(256), LDS_BYTES, stream, p);
}
```
